# Optimizing an MI355X kernel written in HIP

```python
import math
import jax, jax.numpy as jnp
from jax import lax
import numpy as np

D_MODEL = 1024
BATCH = 4
SEQ = 8192
DEPTH = 1

CHUNK = 64
Q_BLOCK = 128
DA_HEADS = 4
DA_HEAD_DIM = 64
DA_WIDTH = DA_HEADS * 2 * DA_HEAD_DIM
SB_HEADS = 8
SB_HEAD_DIM = 64
SB_WIDTH = SB_HEADS * SB_HEAD_DIM
MIX_WIDTH = DA_WIDTH + SB_WIDTH
IN_WIDTH = 3 * DA_WIDTH + 3 * SB_WIDTH
REL_BUCKETS = 32
REL_MAX_DIST = 128
N_GROUPS = 4
EXPERTS_PER_GROUP = 8
N_EXPERTS = N_GROUPS * EXPERTS_PER_GROUP
TOP_K = 2
EXPERT_HIDDEN = 512
MOE_BLOCK = 256
EPS = 1e-6

kernel_name = "hymba_diff_stickbreak_hmoe_block"


def rms_norm(x, g):
    xf = x.astype(jnp.float32)
    y = xf * lax.rsqrt(jnp.mean(xf * xf, axis=-1, keepdims=True) + EPS)
    return (y * g.astype(jnp.float32)).astype(x.dtype)


def rel_bucket(rel):
    nb = REL_BUCKETS // 2
    max_exact = nb // 2
    base = jnp.where(rel > 0, nb, 0)
    n = jnp.abs(rel)
    nf = jnp.maximum(n, 1).astype(jnp.float32)
    large = max_exact + (jnp.log(nf / max_exact) / math.log(REL_MAX_DIST / max_exact)
                         * (nb - max_exact)).astype(jnp.int32)
    large = jnp.minimum(large, nb - 1)
    return base + jnp.where(n < max_exact, n, large)


def to_blocks(t):
    b, h, s, d = t.shape
    return jnp.transpose(t.reshape(b, h, s // Q_BLOCK, Q_BLOCK, d), (2, 0, 1, 3, 4))


def from_blocks(t):
    nblk, b, h, qb, d = t.shape
    return jnp.transpose(t, (1, 2, 0, 3, 4)).reshape(b, h, nblk * qb, d)


def diff_attention(q1, q2, k1, k2, v, rel_bias, lam):
    s_len = q1.shape[2]
    scale = q1.shape[-1] ** -0.5
    pos_k = jnp.arange(s_len, dtype=jnp.int32)

    def block(args):
        i, q1b, q2b = args
        pos_q = i * Q_BLOCK + jnp.arange(Q_BLOCK, dtype=jnp.int32)
        mask = (pos_k[None, :] // CHUNK) <= (pos_q[:, None] // CHUNK)
        bias = rel_bias[rel_bucket(pos_k[None, :] - pos_q[:, None])]
        bias = jnp.transpose(bias, (2, 0, 1)).astype(jnp.float32)

        def probs(qb, k):
            s = jnp.einsum('bhqd,bhkd->bhqk', qb, k).astype(jnp.float32) * scale + bias
            return jax.nn.softmax(jnp.where(mask, s, -jnp.inf), axis=-1)

        w = probs(q1b, k1) - lam * probs(q2b, k2)
        return jnp.einsum('bhqk,bhkd->bhqd', w.astype(v.dtype), v)

    nblk = s_len // Q_BLOCK
    out = lax.map(block, (jnp.arange(nblk, dtype=jnp.int32), to_blocks(q1), to_blocks(q2)))
    return from_blocks(out)


def stick_breaking(q, k, v):
    s_len = q.shape[2]
    scale = q.shape[-1] ** -0.5
    pos_k = jnp.arange(s_len, dtype=jnp.int32)

    def block(args):
        i, qb = args
        pos_q = i * Q_BLOCK + jnp.arange(Q_BLOCK, dtype=jnp.int32)
        causal = pos_k[None, :] < pos_q[:, None]
        z = jnp.einsum('bhqd,bhkd->bhqk', qb, k).astype(jnp.float32) * scale
        log_1m = jnp.where(causal, jax.nn.log_sigmoid(-z), 0.0)
        between = lax.cumsum(log_1m, axis=3, reverse=True) - log_1m
        a = jnp.where(causal, jnp.exp(jax.nn.log_sigmoid(z) + between), 0.0)
        return jnp.einsum('bhqk,bhkd->bhqd', a.astype(v.dtype), v)

    nblk = s_len // Q_BLOCK
    out = lax.map(block, (jnp.arange(nblk, dtype=jnp.int32), to_blocks(q)))
    return from_blocks(out)


def hier_moe(h, wg, bg, we, be, w1, w3, w2):
    bsz, s_len, d = h.shape
    n = bsz * s_len
    hf = h.reshape(n, d)
    pg = jax.nn.softmax((hf @ wg + bg).astype(jnp.float32), axis=-1)
    gsel = jnp.argmax(pg, axis=-1).astype(jnp.int32)
    pg_sel = jnp.max(pg, axis=-1)
    le = (hf @ we + be).astype(jnp.float32).reshape(n, N_GROUPS, EXPERTS_PER_GROUP)
    le = jnp.take_along_axis(le, gsel[:, None, None], axis=1)[:, 0]
    p_top, e_loc = lax.top_k(jax.nn.softmax(le, axis=-1), TOP_K)
    gate = pg_sel[:, None] * p_top / jnp.sum(p_top, axis=-1, keepdims=True)

    eid = (gsel[:, None] * EXPERTS_PER_GROUP + e_loc.astype(jnp.int32)).reshape(-1)
    tok = jnp.repeat(jnp.arange(n, dtype=jnp.int32), TOP_K)
    gflat = gate.reshape(-1)
    order = jnp.argsort(eid)
    s_eid, s_tok, s_gate = eid[order], tok[order], gflat[order]
    counts = jnp.zeros((N_EXPERTS,), jnp.int32).at[eid].add(1)
    starts = jnp.cumsum(counts) - counts
    padded = (counts + MOE_BLOCK - 1) // MOE_BLOCK * MOE_BLOCK
    pad_ends = jnp.cumsum(padded)
    pad_starts = pad_ends - padded
    dest = pad_starts[s_eid] + (jnp.arange(n * TOP_K, dtype=jnp.int32) - starts[s_eid])
    cap = n * TOP_K + N_EXPERTS * MOE_BLOCK
    tok_buf = jnp.full((cap,), n, jnp.int32).at[dest].set(s_tok)
    gate_buf = jnp.zeros((cap,), jnp.float32).at[dest].set(s_gate)
    nb = cap // MOE_BLOCK
    blk_e = jnp.minimum(jnp.searchsorted(pad_ends, jnp.arange(nb, dtype=jnp.int32) * MOE_BLOCK,
                                         side='right'), N_EXPERTS - 1).astype(jnp.int32)
    h_pad = jnp.concatenate([hf, jnp.zeros((1, d), hf.dtype)], axis=0)
    xs = h_pad[tok_buf].reshape(nb, MOE_BLOCK, d)

    def expert_block(args):
        xb, e = args
        return (jax.nn.silu(xb @ w1[e]) * (xb @ w3[e])) @ w2[e]

    ys = lax.map(expert_block, (xs, blk_e)).reshape(cap, d)
    ys = ys * gate_buf[:, None].astype(ys.dtype)
    out = jnp.zeros((n + 1, d), ys.dtype).at[tok_buf].add(ys)[:n]
    return out.reshape(bsz, s_len, d)


def setup_inputs(seed: int = 0) -> dict:
    key = jax.random.key(seed)
    ks = jax.random.split(key, 24)
    f32 = jnp.float32
    nrm = lambda k, shape, s: jax.random.normal(k, shape, f32) * s
    gain = lambda k, shape: 1.0 + 0.02 * jax.random.normal(k, shape, f32)
    return {
        "x": jax.random.normal(ks[0], (BATCH, SEQ, D_MODEL), f32),
        "g_attn": gain(ks[1], (DEPTH, D_MODEL)),
        "w_in": nrm(ks[2], (DEPTH, D_MODEL, IN_WIDTH), D_MODEL ** -0.5),
        "qn_g": gain(ks[3], (DEPTH, DA_HEAD_DIM)),
        "kn_g": gain(ks[4], (DEPTH, DA_HEAD_DIM)),
        "lam_q1": nrm(ks[5], (DEPTH, DA_HEAD_DIM), 0.1),
        "lam_k1": nrm(ks[6], (DEPTH, DA_HEAD_DIM), 0.1),
        "lam_q2": nrm(ks[7], (DEPTH, DA_HEAD_DIM), 0.1),
        "lam_k2": nrm(ks[8], (DEPTH, DA_HEAD_DIM), 0.1),
        "subln_g": gain(ks[9], (DEPTH, 2 * DA_HEAD_DIM)),
        "sb_out_g": gain(ks[10], (DEPTH, SB_HEAD_DIM)),
        "rel_bias": nrm(ks[11], (REL_BUCKETS, DA_HEADS), 0.5),
        "w_o": nrm(ks[12], (DEPTH, MIX_WIDTH, D_MODEL), MIX_WIDTH ** -0.5),
        "g_ffn": gain(ks[13], (DEPTH, D_MODEL)),
        "w_router_g": nrm(ks[14], (DEPTH, D_MODEL, N_GROUPS), D_MODEL ** -0.5),
        "b_router_g": nrm(ks[15], (DEPTH, N_GROUPS), 0.01),
        "w_router_e": nrm(ks[16], (DEPTH, D_MODEL, N_EXPERTS), D_MODEL ** -0.5),
        "b_router_e": nrm(ks[17], (DEPTH, N_EXPERTS), 0.01),
        "w1": nrm(ks[18], (DEPTH, N_EXPERTS, D_MODEL, EXPERT_HIDDEN), D_MODEL ** -0.5),
        "w3": nrm(ks[19], (DEPTH, N_EXPERTS, D_MODEL, EXPERT_HIDDEN), D_MODEL ** -0.5),
        "w2": nrm(ks[20], (DEPTH, N_EXPERTS, EXPERT_HIDDEN, D_MODEL), EXPERT_HIDDEN ** -0.5),
    }


def reference(x, g_attn, w_in, qn_g, kn_g, lam_q1, lam_k1, lam_q2, lam_k2, subln_g,
              sb_out_g, rel_bias, w_o, g_ffn, w_router_g, b_router_g, w_router_e,
              b_router_e, w1, w3, w2):
    bsz, s_len, _ = x.shape
    cut = np.cumsum([DA_WIDTH, DA_WIDTH, DA_WIDTH, SB_WIDTH, SB_WIDTH]).tolist()
    for l in range(DEPTH):
        lambda_init = 0.8 - 0.6 * math.exp(-0.3 * l)
        h = rms_norm(x, g_attn[l])
        proj = h @ w_in[l]
        dq, dk, dv, sq, sk, sv = jnp.split(proj, cut, axis=-1)

        dq = jnp.transpose(dq.reshape(bsz, s_len, DA_HEADS, 2, DA_HEAD_DIM), (3, 0, 2, 1, 4))
        dk = jnp.transpose(dk.reshape(bsz, s_len, DA_HEADS, 2, DA_HEAD_DIM), (3, 0, 2, 1, 4))
        dq = rms_norm(dq, qn_g[l])
        dk = rms_norm(dk, kn_g[l])
        dv = jnp.transpose(dv.reshape(bsz, s_len, DA_HEADS, 2 * DA_HEAD_DIM), (0, 2, 1, 3))
        lam = (jnp.exp(jnp.sum(lam_q1[l] * lam_k1[l]).astype(jnp.float32))
               - jnp.exp(jnp.sum(lam_q2[l] * lam_k2[l]).astype(jnp.float32)) + lambda_init)
        o_da = diff_attention(dq[0], dq[1], dk[0], dk[1], dv, rel_bias, lam)
        o_da = rms_norm(o_da, subln_g[l]) * (1.0 - lambda_init)
        o_da = jnp.transpose(o_da, (0, 2, 1, 3)).reshape(bsz, s_len, DA_WIDTH)

        to_heads = lambda t: jnp.transpose(t.reshape(bsz, s_len, SB_HEADS, SB_HEAD_DIM), (0, 2, 1, 3))
        o_sb = stick_breaking(to_heads(sq), to_heads(sk), to_heads(sv))
        o_sb = rms_norm(o_sb, sb_out_g[l])
        o_sb = jnp.transpose(o_sb, (0, 2, 1, 3)).reshape(bsz, s_len, SB_WIDTH)

        x = x + jnp.concatenate([o_da, o_sb], axis=-1) @ w_o[l]

        h2 = rms_norm(x, g_ffn[l])
        x = x + hier_moe(h2, w_router_g[l], b_router_g[l], w_router_e[l], b_router_e[l],
                         w1[l], w3[l], w2[l])
    return x
```

```cpp
#include <hip/hip_runtime.h>
#include <hip/hip_bf16.h>
#include <cstdio>
#include <cstdint>
#include <cmath>
namespace pg8 {
#define PG8_LAS __attribute__((address_space(3)))
typedef unsigned short bf16_t;
typedef short bf16x8 __attribute__((ext_vector_type(8)));
typedef float f32x4 __attribute__((ext_vector_type(4)));
typedef float f32x2 __attribute__((ext_vector_type(2)));
typedef unsigned u32x4 __attribute__((ext_vector_type(4)));
constexpr int BM = 256, BK = 64, HALF = 128, HTB = HALF * BK * 2  , STAGE_BYTES = 8 * HTB, NXCD = 8, WGM = 8;

__host__ __device__ __forceinline__ int lds_byte(int r, int c) { const int st = (r >> 4) * 2 + (c >> 5), rr = r & 15, cc = c & 31, ob = rr * 64 + cc * 2; return st * 1024 + (ob ^ (((ob >> 9) & 1) << 5)); }
__host__ __device__ __forceinline__ void stage_rc(int b, int& R, int& C) { const int st = b / 1024, sb = b % 1024, swz = sb ^ (((sb >> 9) & 1) << 5); R = (st >> 1) * 16 + swz / 64; C = (st & 1) * 32 + (swz % 64) / 2; }
__host__ __device__ __forceinline__ int perm32(int rho) { const int n = rho >> 4, i = rho & 15; return 8 * (i >> 2) + 4 * n + (i & 3); }

struct Unit { int pm, pn, pb, a0, a1; };
struct Gemm { const bf16_t* A; const bf16_t* Bt; int K; };

struct StaticOrder {
    int nM, nN, nwg, G, c;
    __host__ __device__ void init(int nM_, int nN_, int G_, int c_) { nM = nM_; nN = nN_; nwg = nM * nN; G = G_; c = c_; }
    __host__ __device__ bool next(int i, Unit& u) const {
        const long L = (long)i * G + c; if (L >= nwg) return false;
        int wgid = (int)L; { const int q = nwg / NXCD, r = nwg % NXCD, xcd = wgid % NXCD, off = wgid / NXCD; wgid = (xcd < r ? xcd * (q + 1) : r * (q + 1) + (xcd - r) * q) + off; }
        const int nig = WGM * nN, gid = wgid / nig, fm = gid * WGM, gsz = (nM - fm) < WGM ? (nM - fm) : WGM;
        u.pm = fm + ((wgid % nig) % gsz); u.pn = (wgid % nig) / gsz; u.pb = u.pn; u.a0 = 0; u.a1 = 0; return true;
    }
    __device__ __forceinline__ unsigned arow_tok(const Unit&, int) const { return 0u; }
    __device__ __forceinline__ void done_unit(const Unit&) const {}
};

__device__ __forceinline__ unsigned cvt_pk_bf16(float lo, float hi) { unsigned r; asm volatile("v_cvt_pk_bf16_f32 %0, %1, %2" : "=v"(r) : "v"(lo), "v"(hi)); return r; }

typedef int v8i32 __attribute__((ext_vector_type(8)));
typedef unsigned u32x8 __attribute__((ext_vector_type(8)));
template <class Epi, class Sched, bool GATHER, int EB = 2>
__device__ __forceinline__ void gemm_phase(PG8_LAS unsigned char* lds, const Gemm g, const Sched& S, const Epi& E) {
    const int tid = threadIdx.x, wid = __builtin_amdgcn_readfirstlane(tid >> 6), lane = tid & 63, wr = wid >> 2, wc = wid & 3, fr = lane & 15, fq = lane >> 4;
    const int K = g.K; int nt = K * EB / (BK * 2); asm volatile("" : "+s"(nt));
    unsigned voffA[2], voffB[2];
#pragma unroll
    for (int i = 0; i < 2; ++i) { int R, C; stage_rc(tid * 16 + i * 8192, R, C); const int Rb = (R & ~31) + perm32(R & 31);
        voffA[i] = (unsigned)(R * K * EB + C * 2); voffB[i] = (unsigned)(Rb * K * EB + C * 2); }
    const size_t kstep = (size_t)(BK * 2);
    const size_t hstep = (size_t)HALF * K * EB;
    const size_t tstep = 2 * hstep;
    const unsigned ldsw = (unsigned)wid * 1024u;
    const int aoff = EB == 2 ? lds_byte(wr * 64 + fr, fq * 8) : lds_byte(wr * 64 + fr, fq * 16), boff = EB == 2 ? lds_byte(wc * 32 + fr, fq * 8) : lds_byte(wc * 32 + fr, fq * 16);
#define PG8_SA(b, h) (((b) * 2 + (h)) * HTB)
#define PG8_SB(b, h) ((4 + (b) * 2 + (h)) * HTB)
#define PG8_STAGE(bufoff, gbase, voff) do { _Pragma("unroll") for (int _i = 0; _i < 2; ++_i) { unsigned _o = (voff)[_i]; if constexpr (EB == 1) asm volatile("" : "+v"(_o));     \
        __builtin_amdgcn_global_load_lds((const unsigned*)((const char*)(gbase) + _o), (PG8_LAS unsigned*)(lds + (bufoff) + ldsw + _i * 8192), 16, 0, 0); } } while (0)
#define PG8_STAGE_A(bufoff, h, aptr, usenext) do { if constexpr (GATHER) { const unsigned _p = (usenext) ? tkn[h] : tkc[h]; unsigned _v[2]; \
            _v[0] = (_p & 0xffffu) * arowb + (cpk & 0xffu); _v[1] = (_p >> 16) * arowb + (cpk >> 8); PG8_STAGE(bufoff, aptr, _v); } \
        else { PG8_STAGE(bufoff, (aptr) + (h) * hstep, voffA); } } while (0)
#define PG8_LD16(off) (*(const PG8_LAS u32x4*)(lds + (off)))
#define PG8_CAT(lo, hi) __builtin_shufflevector(lo, hi, 0, 1, 2, 3, 4, 5, 6, 7)
#define PG8_LDA(dst, dst8, b, h) do { _Pragma("unroll") for (int m = 0; m < 4; ++m) { \
        if constexpr (EB == 2) { _Pragma("unroll") for (int k = 0; k < 2; ++k) dst[m][k] = *(const PG8_LAS bf16x8*)(lds + PG8_SA(b, h) + aoff + m * 2048 + k * 1024); } \
        else { const u32x4 _l = PG8_LD16(PG8_SA(b, h) + aoff + m * 2048), _h = PG8_LD16(PG8_SA(b, h) + aoff + m * 2048 + 16); dst8[m] = PG8_CAT(_l, _h); } } } while (0)
#define PG8_LDB(dst, dst8, b, h) do { _Pragma("unroll") for (int n = 0; n < 2; ++n) { \
        if constexpr (EB == 2) { _Pragma("unroll") for (int k = 0; k < 2; ++k) dst[n][k] = *(const PG8_LAS bf16x8*)(lds + PG8_SB(b, h) + boff + n * 2048 + k * 1024); } \
        else { const u32x4 _l = PG8_LD16(PG8_SB(b, h) + boff + n * 2048), _h = PG8_LD16(PG8_SB(b, h) + boff + n * 2048 + 16); dst8[n] = PG8_CAT(_l, _h); } } } while (0)
#define PG8_MMA(ai, bj, At, At8, Bt, Bt8) do { __builtin_amdgcn_s_setprio(1); _Pragma("unroll") for (int m = 0; m < 4; ++m) _Pragma("unroll") for (int n = 0; n < 2; ++n) { \
        if constexpr (EB == 2) { _Pragma("unroll") for (int k = 0; k < 2; ++k) acc[ai][bj][m][n] = __builtin_amdgcn_mfma_f32_16x16x32_bf16(Bt[n][k], At[m][k], acc[ai][bj][m][n], 0, 0, 0); } \
        else { asm volatile("v_mfma_scale_f32_16x16x128_f8f6f4 %0, %1, %2, %0, %3, %3 op_sel_hi:[0,0,0]" : "+v"(acc[ai][bj][m][n]) : "v"(Bt8[n]), "v"(At8[m]), "v"(one_scale)); } } \
        __builtin_amdgcn_s_setprio(0); } while (0)
#define PG8_WAIT_V(n) asm volatile("s_waitcnt vmcnt(" #n ")" ::: "memory")
#define PG8_WAIT_L(n) asm volatile("s_waitcnt lgkmcnt(" #n ")" ::: "memory")
#define PG8_BAR __builtin_amdgcn_s_barrier()
#define PG8_SCHED __builtin_amdgcn_sched_barrier(0)
    Unit cur, nxt; int ui = 0;
    if (!S.next(0, cur)) return;
    unsigned tkc[2] = {0u, 0u}, tkn[2] = {0u, 0u}, cpk = 0u; const unsigned arowb = (unsigned)(K * EB);
    if constexpr (GATHER) {
        int R0, C0, R1, C1; stage_rc(tid * 16, R0, C0); stage_rc(tid * 16 + 8192, R1, C1); cpk = (unsigned)(C0 * 2) | ((unsigned)(C1 * 2) << 8);
#pragma unroll
        for (int h = 0; h < 2; ++h) tkc[h] = S.arow_tok(cur, h * HALF + R0) | (S.arow_tok(cur, h * HALF + R1) << 16);
    }
    f32x4 acc[2][2][4][2];
#pragma unroll
    for (int a = 0; a < 2; ++a)
#pragma unroll
        for (int b = 0; b < 2; ++b)
#pragma unroll
            for (int m = 0; m < 4; ++m)
#pragma unroll
                for (int n = 0; n < 2; ++n) acc[a][b][m][n] = (f32x4){0.f, 0.f, 0.f, 0.f};
    const unsigned one_scale = 0x7f7f7f7fu;
    bf16x8 At[4][2], B0[2][2], B1[2][2]; u32x8 At8[4], B08[2], B18[2];
    const char* cA = GATHER ? (const char*)g.A : (const char*)g.A + (size_t)cur.pm * tstep; const char* cB = (const char*)g.Bt + (size_t)cur.pb * tstep;
    PG8_STAGE(PG8_SB(0, 0), cB, voffB); PG8_STAGE(PG8_SB(0, 1), cB + hstep, voffB); PG8_STAGE_A(PG8_SA(0, 0), 0, cA, false); PG8_STAGE_A(PG8_SA(0, 1), 1, cA, false);
    if (wr == 1) PG8_BAR;
    PG8_WAIT_V(2); PG8_BAR;
    PG8_STAGE(PG8_SB(1, 0), cB + kstep, voffB); PG8_STAGE_A(PG8_SA(1, 0), 0, cA + kstep, false); PG8_STAGE(PG8_SB(1, 1), cB + hstep + kstep, voffB);
    PG8_WAIT_V(6); PG8_BAR;
    for (;;) {
        const bool has_next = S.next(ui + 1, nxt);
        if constexpr (GATHER) { if (has_next) { int R0, C0, R1, C1; stage_rc(tid * 16, R0, C0); stage_rc(tid * 16 + 8192, R1, C1);
#pragma unroll
            for (int h = 0; h < 2; ++h) tkn[h] = S.arow_tok(nxt, h * HALF + R0) | (S.arow_tok(nxt, h * HALF + R1) << 16); } }
        const char* nA = GATHER ? (const char*)g.A : (has_next ? (const char*)g.A + (size_t)nxt.pm * tstep : cA);
        const char* nB = has_next ? (const char*)g.Bt + (size_t)nxt.pb * tstep : cB;
        for (int t = 0; t < nt; t += 2) {
            const bool last = (t == nt - 2);
            const bool un = last && has_next;
            const char* a1 = cA + (size_t)(t + 1) * kstep;
            const char* a2 = last ? nA : cA + (size_t)(t + 2) * kstep; const char* b2 = last ? nB : cB + (size_t)(t + 2) * kstep;
            const char* a3 = a2 + kstep; const char* b3 = b2 + kstep;
            PG8_LDB(B0, B08, 0, 0); PG8_LDB(B1, B18, 0, 1); PG8_SCHED; PG8_LDA(At, At8, 0, 0); PG8_STAGE_A(PG8_SA(1, 1), 1, a1, false);
            PG8_WAIT_V(8); PG8_WAIT_L(0); PG8_BAR; PG8_MMA(0, 0, At, At8, B0, B08); PG8_MMA(0, 1, At, At8, B1, B18); PG8_BAR; PG8_SCHED;
            PG8_LDA(At, At8, 0, 1); PG8_STAGE(PG8_SB(0, 0), b2, voffB); PG8_STAGE(PG8_SB(0, 1), b2 + hstep, voffB); PG8_STAGE_A(PG8_SA(0, 0), 0, a2, un);
            PG8_WAIT_V(8); PG8_WAIT_L(0); PG8_BAR; PG8_MMA(1, 0, At, At8, B0, B08); PG8_MMA(1, 1, At, At8, B1, B18); PG8_BAR; PG8_SCHED;
            PG8_LDB(B0, B08, 1, 0); PG8_LDB(B1, B18, 1, 1); PG8_SCHED; PG8_LDA(At, At8, 1, 0); PG8_STAGE_A(PG8_SA(0, 1), 1, a2, un);
            PG8_WAIT_V(8); PG8_WAIT_L(0); PG8_BAR; PG8_MMA(0, 0, At, At8, B0, B08); PG8_MMA(0, 1, At, At8, B1, B18); PG8_BAR; PG8_SCHED;
            PG8_LDA(At, At8, 1, 1); PG8_STAGE(PG8_SB(1, 0), b3, voffB); PG8_STAGE(PG8_SB(1, 1), b3 + hstep, voffB); PG8_STAGE_A(PG8_SA(1, 0), 0, a3, un);
            PG8_WAIT_V(8); PG8_WAIT_L(0); PG8_BAR; PG8_MMA(1, 0, At, At8, B0, B08); PG8_MMA(1, 1, At, At8, B1, B18); PG8_BAR; PG8_SCHED;
        }
        if (wr == 0) PG8_BAR;
        if constexpr (EB == 1) asm volatile("s_nop 15\n\ts_nop 7" ::: "memory");
        E(acc, cur, wr, wc, fr, fq);
        S.done_unit(cur);
        if (!has_next) break;
#pragma unroll
        for (int a = 0; a < 2; ++a)
#pragma unroll
            for (int b = 0; b < 2; ++b)
#pragma unroll
                for (int m = 0; m < 4; ++m)
#pragma unroll
                    for (int n = 0; n < 2; ++n) acc[a][b][m][n] = (f32x4){0.f, 0.f, 0.f, 0.f};
        cur = nxt; cA = nA; cB = nB; ++ui;
        if constexpr (GATHER) { tkc[0] = tkn[0]; tkc[1] = tkn[1]; }
        if (wr == 1) PG8_BAR;
    }
    PG8_WAIT_V(0);
    PG8_BAR;
#undef PG8_SA
#undef PG8_SB
#undef PG8_STAGE
#undef PG8_STAGE_A
#undef PG8_LDA
#undef PG8_LDB
#undef PG8_MMA
#undef PG8_LD16
#undef PG8_CAT
#undef PG8_WAIT_V
#undef PG8_WAIT_L
#undef PG8_BAR
#undef PG8_SCHED
}
}
namespace att {
using bf16x8 = __attribute__((ext_vector_type(8))) short;
using s16x4 = __attribute__((ext_vector_type(4))) short;
using f32x16 = __attribute__((ext_vector_type(16))) float;
using u32x4 = __attribute__((ext_vector_type(4))) unsigned;
using u32x2 = __attribute__((ext_vector_type(2))) unsigned;
using f32x4v = __attribute__((ext_vector_type(4))) float;
typedef unsigned short bf16;
#ifndef PROJ_PAD
#define PROJ_PAD (37 * 1024 + 256)
#endif
constexpr int SEQ = 8192, MIXP = 1024, NTOKC = 32768, TILEB = 64 * 128;
constexpr long BSTR = (long)SEQ * 128 + PROJ_PAD;
constexpr long GRPB = 4 * BSTR;
__device__ __forceinline__ const bf16* proj_slab(const bf16* PROJ, int g, int b) { return (const bf16*)((const char*)PROJ + (long)(g * 4 + b) * BSTR); }
constexpr int C_DQ = 0, C_DK = 512, C_DV = 1024, C_SQ = 1536, C_SK = 2048, C_SV = 2560;
constexpr float LOG2E = 1.4426950408889634f;
constexpr float QSCALE = 0.125f * LOG2E;
__device__ __forceinline__ int crow(int r, int hi) { return (r & 3) + 8 * (r >> 2) + 4 * hi; }
template <int OFF = 0> __device__ __forceinline__ void glds16(const void* gsrc, unsigned lds_dst) { unsigned keep;
    asm volatile("s_mov_b32 %0, m0\n\ts_mov_b32 m0, %2\n\ts_nop 0\n\tglobal_load_lds_dwordx4 %1, off offset:%c3\n\ts_mov_b32 m0, %0" : "=&s"(keep) : "v"(gsrc), "s"(lds_dst), "i"(OFF) : "memory"); }
template <int OFF = 0> __device__ __forceinline__ void glds16s(unsigned voff, const void* sbase, unsigned lds_dst) { unsigned keep;
    asm volatile("s_mov_b32 %0, m0\n\ts_mov_b32 m0, %2\n\ts_nop 0\n\tglobal_load_lds_dwordx4 %1, %3 offset:%c4\n\ts_mov_b32 m0, %0" : "=&s"(keep) : "v"(voff), "s"(lds_dst), "s"(sbase), "i"(OFF) : "memory"); }
typedef float f32x2_t __attribute__((ext_vector_type(2))); typedef __bf16 bf16x2_t __attribute__((ext_vector_type(2)));
__device__ __forceinline__ unsigned cvtpk(float lo, float hi) { f32x2_t v = {lo, hi}; bf16x2_t b = __builtin_convertvector(v, bf16x2_t); return __builtin_bit_cast(unsigned, b); }
typedef __attribute__((address_space(3))) const char* lds_cptr;
typedef __attribute__((address_space(3))) char* lds_ptr;
typedef short v4i16_t __attribute__((ext_vector_type(4)));
__device__ __forceinline__ s16x4 vtr(lds_cptr p) { return __builtin_bit_cast(s16x4, __builtin_amdgcn_ds_read_tr16_b64_v4i16((__attribute__((address_space(3))) v4i16_t*)p)); }
__device__ __forceinline__ float swap_max(float m) { auto rr = __builtin_amdgcn_permlane32_swap(__float_as_uint(m), __float_as_uint(m), false, false); return fmaxf(__uint_as_float(rr[0]), __uint_as_float(rr[1])); }
__device__ __forceinline__ float swap_sum(float m) { auto rr = __builtin_amdgcn_permlane32_swap(__float_as_uint(m), __float_as_uint(m), false, false); return __uint_as_float(rr[0]) + __uint_as_float(rr[1]); }
#define ATT_WAIT_BAR(N) asm volatile("s_waitcnt vmcnt(" #N ") lgkmcnt(0)\n\ts_barrier" ::: "memory")
#define ATT_LBAR() asm volatile("s_waitcnt lgkmcnt(0)\n\ts_barrier" ::: "memory")
#define ATT_MFMA(a, b, c) __builtin_amdgcn_mfma_f32_32x32x16_bf16(a, b, c, 0, 0, 0)

struct KQ { lds_cptr a[4]; };
__device__ __forceinline__ KQ kq_make(lds_cptr base, int r32, int hi) { KQ k;
#pragma unroll
    for (int d0 = 0; d0 < 4; ++d0) k.a[d0] = base + r32 * 128 + (((2 * d0 + hi) ^ ((r32 >> 1) & 7)) << 4);
    return k; }
__device__ __forceinline__ void qkt(f32x16& p0, f32x16& p1, const KQ& kq, int slot, const bf16x8* qr, const f32x16 z = f32x16{}) {
#pragma unroll
    for (int d0 = 0; d0 < 4; ++d0) {
        const bf16x8 b0 = *(const __attribute__((address_space(3))) bf16x8*)(kq.a[d0] + slot);
        const bf16x8 b1 = *(const __attribute__((address_space(3))) bf16x8*)(kq.a[d0] + slot + 4096);
        if (d0 == 0) { p0 = ATT_MFMA(b0, qr[0], z); p1 = ATT_MFMA(b1, qr[0], z); }
        else { p0 = ATT_MFMA(b0, qr[d0], p0); p1 = ATT_MFMA(b1, qr[d0], p1); } }
}
template <int NDB, bool FENCE = true> __device__ __forceinline__ void pv(f32x16* o, lds_cptr vp, const u32x4* pw) {
#pragma unroll
    for (int db = 0; db < NDB; ++db) {
#pragma unroll
        for (int ks = 0; ks < 4; ++ks) {
            const s16x4 lo = vtr(vp + db * 4096 + ks * 1024), hi = vtr(vp + db * 4096 + ks * 1024 + 512);
            const bf16x8 vf = (bf16x8){lo[0], lo[1], lo[2], lo[3], hi[0], hi[1], hi[2], hi[3]};
            o[db] = ATT_MFMA(vf, __builtin_bit_cast(bf16x8, pw[ks]), o[db]); }
        if (FENCE) __builtin_amdgcn_sched_barrier(0); }
}
__device__ __forceinline__ void pack_p(u32x4* pw, const f32x16& p0, const f32x16& p1) {
    pw[0] = (u32x4){cvtpk(p0[0], p0[1]), cvtpk(p0[2], p0[3]), cvtpk(p0[4], p0[5]), cvtpk(p0[6], p0[7])};
    pw[1] = (u32x4){cvtpk(p0[8], p0[9]), cvtpk(p0[10], p0[11]), cvtpk(p0[12], p0[13]), cvtpk(p0[14], p0[15])};
    pw[2] = (u32x4){cvtpk(p1[0], p1[1]), cvtpk(p1[2], p1[3]), cvtpk(p1[4], p1[5]), cvtpk(p1[6], p1[7])};
    pw[3] = (u32x4){cvtpk(p1[8], p1[9]), cvtpk(p1[10], p1[11]), cvtpk(p1[12], p1[13]), cvtpk(p1[14], p1[15])};
}

struct Tabs { const __attribute__((address_space(3))) float* btab;
              const __attribute__((address_space(3))) float* gsub;
              const __attribute__((address_space(3))) float* gsb;
              float lam; bool online; };

constexpr int DA_KSLOT = 16384, DA_VBASE = 65536, DA_VSLOT = 16384, DA_XCH = 0  , DA_STG = 65536  , DA_STG_ROW = 272;
#define DA_SBAR() __builtin_amdgcn_sched_barrier(0)
#define DA_PIN(x) asm volatile("" : "+v"(x))
__device__ __forceinline__ float da_max3(float a, float b, float c) { float r; asm("v_max3_f32 %0, %1, %2, %3" : "=v"(r) : "v"(a), "v"(b), "v"(c)); return r; }
__device__ __forceinline__ float da_rowmax(f32x16& p0, f32x16& p1) {
    asm volatile("s_nop 15\n\ts_nop 7" : "+v"(p0), "+v"(p1));
    float a = da_max3(p0[0], p0[1], p1[0]), b = da_max3(p0[2], p0[3], p1[1]); a = da_max3(a, p1[2], p1[3]);
#pragma unroll
    for (int r = 4; r < 16; r += 4) { a = da_max3(a, p0[r], p0[r + 1]); b = da_max3(b, p0[r + 2], p0[r + 3]); a = da_max3(a, p1[r], p1[r + 1]); b = da_max3(b, p1[r + 2], p1[r + 3]); }
    return swap_max(fmaxf(a, b));
}
struct DaCtx { KQ kq; lds_cptr vp0; const __attribute__((address_space(3))) float* bt; int NT, cq, qpos, hi; unsigned kvoff, vvoff, kdst, vdst; const char* kbase; const char* vbase; };
__device__ __forceinline__ void da_near_bias(f32x16& p0, f32x16& p1, const DaCtx& C, int t) {
    const int rb = 64 * t + 4 * C.hi - C.qpos;
#pragma unroll
    for (int r = 0; r < 16; ++r) { const int rel = rb + (r & 3) + 8 * (r >> 2); int i0 = rel < -128 ? -128 : rel; int i1 = rel + 32 < -128 ? -128 : rel + 32;
        p0[r] += C.bt[i0 + 128]; p1[r] += C.bt[i1 + 128]; }
}
template <bool ONLINE> __device__ __forceinline__ void da_step_plain(int t, f32x16& sc0, f32x16& sc1, f32x16& sn0, f32x16& sn1, const u32x4* pwp, u32x4* pwc, f32x16* o, float& mhat, float& l, const bf16x8* qr, const DaCtx& C) {
    if (t >= 1 && t - 1 <= C.cq) pv<4>(o, C.vp0 + ((t - 1) & 3) * DA_VSLOT, pwp);
    if (t <= C.cq) {
        if (t >= C.NT - 4) da_near_bias(sc0, sc1, C, t);
        const float mx = ONLINE ? da_rowmax(sc0, sc1) : 0.f;
        if (ONLINE && (t == 0 || __any(mx > 8.f))) {
            const float dl = t == 0 ? mx : fmaxf(mx, 0.f), f = __builtin_amdgcn_exp2f(-dl);
            mhat += dl; l *= f;
#pragma unroll
            for (int r = 0; r < 16; ++r) { sc0[r] -= dl; sc1[r] -= dl; }
            if (t != 0) {
#pragma unroll
                for (int db = 0; db < 4; ++db)
#pragma unroll
                    for (int r = 0; r < 16; ++r) o[db][r] *= f;
            }
        }
        float sa = 0.f, sb = 0.f;
#pragma unroll
        for (int r = 0; r < 16; ++r) { sc0[r] = __builtin_amdgcn_exp2f(sc0[r]); sc1[r] = __builtin_amdgcn_exp2f(sc1[r]); sa += sc0[r]; sb += sc1[r]; }
        l += sa + sb;
        pack_p(pwc, sc0, sc1);
    }
    if (t + 1 < C.NT && t + 1 <= C.cq) {
        f32x16 ci;
#pragma unroll
        for (int r = 0; r < 16; ++r) ci[r] = ONLINE ? -mhat : 0.f;
        qkt(sn0, sn1, C.kq, ((t + 1) & 3) * DA_KSLOT, qr, ci);
    }
}
template <bool PV, bool QK, bool FIRST, bool ONLINE> __device__ __forceinline__ void da_step_hot(int t, f32x16& sc0, f32x16& sc1, f32x16& sn0, f32x16& sn1, const u32x4* pwp, u32x4* pwc, f32x16* o, float& mhat, float& l, const bf16x8* qr, const DaCtx& C) {
    if (t >= C.NT - 4) da_near_bias(sc0, sc1, C, t);
    if (!ONLINE) { DA_PIN(sc0); DA_PIN(sc1); DA_SBAR(); }
    const float mx = ONLINE ? da_rowmax(sc0, sc1) : 0.f;
    const bool resc = ONLINE && (FIRST || __any(mx > 8.f)); float f = 1.f;
    if (resc) { const float dl = FIRST ? mx : fmaxf(mx, 0.f); f = __builtin_amdgcn_exp2f(-dl); mhat += dl; l *= f;
#pragma unroll
        for (int r = 0; r < 16; ++r) { sc0[r] -= dl; sc1[r] -= dl; } }
    f32x16 ci;
#pragma unroll
    for (int r = 0; r < 16; ++r) ci[r] = ONLINE ? -mhat : 0.f;
    if (ONLINE) DA_PIN(ci);
    const lds_cptr vpt = C.vp0 + ((t - 1) & 3) * DA_VSLOT; const int kslot = ((t + 1) & 3) * DA_KSLOT; const KQ& kq = C.kq;
    s16x4 fl0, fh0, fl1, fh1, fl2, fh2, fl3, fh3, fl4, fh4; bf16x8 fk0, fk1, fk2, fk3, fk4; float sa = 0.f, sb = 0.f;
#define DA_DMA(j) do { if ((j) < 2) { if (t + 3 < C.NT) { const char* _b = C.kbase + (long)(t + 3) * TILEB; const unsigned _s = (unsigned)(((t + 3) & 3) * DA_KSLOT); \
            if ((j) == 0) glds16s<0>(C.kvoff, _b, (unsigned)__builtin_amdgcn_readfirstlane(C.kdst + _s)); else glds16s<0>(C.kvoff, _b + GRPB, (unsigned)__builtin_amdgcn_readfirstlane(C.kdst + 8192 + _s)); } } \
        else { if (t + 2 < C.NT) { const char* _b = C.vbase + (long)(t + 2) * TILEB; const unsigned _s = (unsigned)(((t + 2) & 3) * DA_VSLOT); \
            if ((j) == 2) glds16s<0>(C.vvoff, _b, (unsigned)__builtin_amdgcn_readfirstlane(C.vdst + _s)); else glds16s<0>(C.vvoff, _b + GRPB, (unsigned)__builtin_amdgcn_readfirstlane(C.vdst + 8192 + _s)); } } } while (0)
    DA_SBAR();
    if constexpr (PV && QK) {
    fl0 = vtr(vpt + 0); fh0 = vtr(vpt + 512); fl1 = vtr(vpt + 1024); fh1 = vtr(vpt + 1536); DA_SBAR();
    fl2 = vtr(vpt + 2048); fh2 = vtr(vpt + 2560); o[0] = ATT_MFMA(((bf16x8){fl0[0], fl0[1], fl0[2], fl0[3], fh0[0], fh0[1], fh0[2], fh0[3]}), __builtin_bit_cast(bf16x8, pwp[0]), o[0]); sc0[0] = __builtin_amdgcn_exp2f(sc0[0]); sc0[1] = __builtin_amdgcn_exp2f(sc0[1]); DA_PIN(sa); DA_PIN(sb); DA_PIN(sc0); DA_PIN(sc1); DA_SBAR();
    fl0 = vtr(vpt + 3072); fh0 = vtr(vpt + 3584); o[0] = ATT_MFMA(((bf16x8){fl1[0], fl1[1], fl1[2], fl1[3], fh1[0], fh1[1], fh1[2], fh1[3]}), __builtin_bit_cast(bf16x8, pwp[1]), o[0]); sc0[2] = __builtin_amdgcn_exp2f(sc0[2]); sc0[3] = __builtin_amdgcn_exp2f(sc0[3]); sa += sc0[0]; sb += sc0[1]; DA_PIN(sa); DA_PIN(sb); DA_PIN(sc0); DA_PIN(sc1); DA_SBAR();
    fl1 = vtr(vpt + 4096); fh1 = vtr(vpt + 4608); o[0] = ATT_MFMA(((bf16x8){fl2[0], fl2[1], fl2[2], fl2[3], fh2[0], fh2[1], fh2[2], fh2[3]}), __builtin_bit_cast(bf16x8, pwp[2]), o[0]); sc0[4] = __builtin_amdgcn_exp2f(sc0[4]); sc0[5] = __builtin_amdgcn_exp2f(sc0[5]); sa += sc0[2]; sb += sc0[3]; DA_PIN(sa); DA_PIN(sb); DA_PIN(sc0); DA_PIN(sc1); DA_SBAR();
    fl2 = vtr(vpt + 5120); fh2 = vtr(vpt + 5632); o[0] = ATT_MFMA(((bf16x8){fl0[0], fl0[1], fl0[2], fl0[3], fh0[0], fh0[1], fh0[2], fh0[3]}), __builtin_bit_cast(bf16x8, pwp[3]), o[0]); sc0[6] = __builtin_amdgcn_exp2f(sc0[6]); sc0[7] = __builtin_amdgcn_exp2f(sc0[7]); sa += sc0[4]; sb += sc0[5]; DA_PIN(sa); DA_PIN(sb); DA_PIN(sc0); DA_PIN(sc1); DA_SBAR();
    fl0 = vtr(vpt + 6144); fh0 = vtr(vpt + 6656); o[1] = ATT_MFMA(((bf16x8){fl1[0], fl1[1], fl1[2], fl1[3], fh1[0], fh1[1], fh1[2], fh1[3]}), __builtin_bit_cast(bf16x8, pwp[0]), o[1]); sc0[8] = __builtin_amdgcn_exp2f(sc0[8]); sc0[9] = __builtin_amdgcn_exp2f(sc0[9]); sa += sc0[6]; sb += sc0[7]; DA_PIN(sa); DA_PIN(sb); DA_PIN(sc0); DA_PIN(sc1); DA_SBAR();
    fl1 = vtr(vpt + 7168); fh1 = vtr(vpt + 7680); o[1] = ATT_MFMA(((bf16x8){fl2[0], fl2[1], fl2[2], fl2[3], fh2[0], fh2[1], fh2[2], fh2[3]}), __builtin_bit_cast(bf16x8, pwp[1]), o[1]); sc0[10] = __builtin_amdgcn_exp2f(sc0[10]); sc0[11] = __builtin_amdgcn_exp2f(sc0[11]); sa += sc0[8]; sb += sc0[9]; DA_PIN(sa); DA_PIN(sb); DA_PIN(sc0); DA_PIN(sc1); DA_SBAR();
    fl2 = vtr(vpt + 8192); fh2 = vtr(vpt + 8704); o[1] = ATT_MFMA(((bf16x8){fl0[0], fl0[1], fl0[2], fl0[3], fh0[0], fh0[1], fh0[2], fh0[3]}), __builtin_bit_cast(bf16x8, pwp[2]), o[1]); sc0[12] = __builtin_amdgcn_exp2f(sc0[12]); sc0[13] = __builtin_amdgcn_exp2f(sc0[13]); sa += sc0[10]; sb += sc0[11]; DA_PIN(sa); DA_PIN(sb); DA_PIN(sc0); DA_PIN(sc1); DA_SBAR();
    fl0 = vtr(vpt + 9216); fh0 = vtr(vpt + 9728); o[1] = ATT_MFMA(((bf16x8){fl1[0], fl1[1], fl1[2], fl1[3], fh1[0], fh1[1], fh1[2], fh1[3]}), __builtin_bit_cast(bf16x8, pwp[3]), o[1]); sc0[14] = __builtin_amdgcn_exp2f(sc0[14]); sc0[15] = __builtin_amdgcn_exp2f(sc0[15]); sa += sc0[12]; sb += sc0[13]; DA_PIN(sa); DA_PIN(sb); DA_PIN(sc0); DA_PIN(sc1); DA_SBAR();
    fl1 = vtr(vpt + 10240); fh1 = vtr(vpt + 10752); o[2] = ATT_MFMA(((bf16x8){fl2[0], fl2[1], fl2[2], fl2[3], fh2[0], fh2[1], fh2[2], fh2[3]}), __builtin_bit_cast(bf16x8, pwp[0]), o[2]); sc1[0] = __builtin_amdgcn_exp2f(sc1[0]); sc1[1] = __builtin_amdgcn_exp2f(sc1[1]); sa += sc0[14]; sb += sc0[15]; DA_PIN(sa); DA_PIN(sb); DA_PIN(sc0); DA_PIN(sc1); DA_SBAR();
    fl2 = vtr(vpt + 11264); fh2 = vtr(vpt + 11776); o[2] = ATT_MFMA(((bf16x8){fl0[0], fl0[1], fl0[2], fl0[3], fh0[0], fh0[1], fh0[2], fh0[3]}), __builtin_bit_cast(bf16x8, pwp[1]), o[2]); sc1[2] = __builtin_amdgcn_exp2f(sc1[2]); sc1[3] = __builtin_amdgcn_exp2f(sc1[3]); sa += sc1[0]; sb += sc1[1]; DA_PIN(sa); DA_PIN(sb); DA_PIN(sc0); DA_PIN(sc1); DA_SBAR();
    fl0 = vtr(vpt + 12288); fh0 = vtr(vpt + 12800); o[2] = ATT_MFMA(((bf16x8){fl1[0], fl1[1], fl1[2], fl1[3], fh1[0], fh1[1], fh1[2], fh1[3]}), __builtin_bit_cast(bf16x8, pwp[2]), o[2]); sc1[4] = __builtin_amdgcn_exp2f(sc1[4]); sc1[5] = __builtin_amdgcn_exp2f(sc1[5]); sa += sc1[2]; sb += sc1[3]; DA_PIN(sa); DA_PIN(sb); DA_PIN(sc0); DA_PIN(sc1); DA_SBAR();
    fl1 = vtr(vpt + 13312); fh1 = vtr(vpt + 13824); o[2] = ATT_MFMA(((bf16x8){fl2[0], fl2[1], fl2[2], fl2[3], fh2[0], fh2[1], fh2[2], fh2[3]}), __builtin_bit_cast(bf16x8, pwp[3]), o[2]); sc1[6] = __builtin_amdgcn_exp2f(sc1[6]); sc1[7] = __builtin_amdgcn_exp2f(sc1[7]); sa += sc1[4]; sb += sc1[5]; DA_PIN(sa); DA_PIN(sb); DA_PIN(sc0); DA_PIN(sc1); DA_SBAR();
    fl2 = vtr(vpt + 14336); fh2 = vtr(vpt + 14848); o[3] = ATT_MFMA(((bf16x8){fl0[0], fl0[1], fl0[2], fl0[3], fh0[0], fh0[1], fh0[2], fh0[3]}), __builtin_bit_cast(bf16x8, pwp[0]), o[3]); sc1[8] = __builtin_amdgcn_exp2f(sc1[8]); sc1[9] = __builtin_amdgcn_exp2f(sc1[9]); sa += sc1[6]; sb += sc1[7]; DA_PIN(sa); DA_PIN(sb); DA_PIN(sc0); DA_PIN(sc1); DA_SBAR();
    fl0 = vtr(vpt + 15360); fh0 = vtr(vpt + 15872); o[3] = ATT_MFMA(((bf16x8){fl1[0], fl1[1], fl1[2], fl1[3], fh1[0], fh1[1], fh1[2], fh1[3]}), __builtin_bit_cast(bf16x8, pwp[1]), o[3]); sc1[10] = __builtin_amdgcn_exp2f(sc1[10]); sc1[11] = __builtin_amdgcn_exp2f(sc1[11]); sa += sc1[8]; sb += sc1[9]; DA_PIN(sa); DA_PIN(sb); DA_PIN(sc0); DA_PIN(sc1); DA_SBAR();
    fk1 = *(const __attribute__((address_space(3))) bf16x8*)(kq.a[0] + kslot + 0); o[3] = ATT_MFMA(((bf16x8){fl2[0], fl2[1], fl2[2], fl2[3], fh2[0], fh2[1], fh2[2], fh2[3]}), __builtin_bit_cast(bf16x8, pwp[2]), o[3]); sc1[12] = __builtin_amdgcn_exp2f(sc1[12]); sc1[13] = __builtin_amdgcn_exp2f(sc1[13]); sa += sc1[10]; sb += sc1[11]; DA_PIN(sa); DA_PIN(sb); DA_PIN(sc0); DA_PIN(sc1); DA_SBAR();
    fk2 = *(const __attribute__((address_space(3))) bf16x8*)(kq.a[0] + kslot + 4096); o[3] = ATT_MFMA(((bf16x8){fl0[0], fl0[1], fl0[2], fl0[3], fh0[0], fh0[1], fh0[2], fh0[3]}), __builtin_bit_cast(bf16x8, pwp[3]), o[3]); sc1[14] = __builtin_amdgcn_exp2f(sc1[14]); sc1[15] = __builtin_amdgcn_exp2f(sc1[15]); sa += sc1[12]; sb += sc1[13]; DA_PIN(sa); DA_PIN(sb); DA_PIN(sc0); DA_PIN(sc1); DA_SBAR();
    fk0 = *(const __attribute__((address_space(3))) bf16x8*)(kq.a[1] + kslot + 0); sn0 = ATT_MFMA(fk1, qr[0], ci); sa += sc1[14]; sb += sc1[15]; pwc[0][0] = cvtpk(sc0[0], sc0[1]); pwc[0][1] = cvtpk(sc0[2], sc0[3]); DA_PIN(pwc[0]); pwc[0][2] = cvtpk(sc0[4], sc0[5]); pwc[0][3] = cvtpk(sc0[6], sc0[7]); DA_PIN(pwc[0]); DA_PIN(sa); DA_PIN(sb); DA_SBAR();
    fk1 = *(const __attribute__((address_space(3))) bf16x8*)(kq.a[1] + kslot + 4096); sn1 = ATT_MFMA(fk2, qr[0], ci); pwc[1][0] = cvtpk(sc0[8], sc0[9]); pwc[1][1] = cvtpk(sc0[10], sc0[11]); DA_PIN(pwc[1]); pwc[1][2] = cvtpk(sc0[12], sc0[13]); pwc[1][3] = cvtpk(sc0[14], sc0[15]); DA_PIN(pwc[1]); DA_PIN(sa); DA_PIN(sb); DA_DMA(0); DA_SBAR();
    fk2 = *(const __attribute__((address_space(3))) bf16x8*)(kq.a[2] + kslot + 0); sn0 = ATT_MFMA(fk0, qr[1], sn0); pwc[2][0] = cvtpk(sc1[0], sc1[1]); pwc[2][1] = cvtpk(sc1[2], sc1[3]); DA_PIN(pwc[2]); pwc[2][2] = cvtpk(sc1[4], sc1[5]); pwc[2][3] = cvtpk(sc1[6], sc1[7]); DA_PIN(pwc[2]); DA_PIN(sa); DA_PIN(sb); DA_SBAR();
    fk0 = *(const __attribute__((address_space(3))) bf16x8*)(kq.a[2] + kslot + 4096); sn1 = ATT_MFMA(fk1, qr[1], sn1); pwc[3][0] = cvtpk(sc1[8], sc1[9]); pwc[3][1] = cvtpk(sc1[10], sc1[11]); DA_PIN(pwc[3]); pwc[3][2] = cvtpk(sc1[12], sc1[13]); pwc[3][3] = cvtpk(sc1[14], sc1[15]); DA_PIN(pwc[3]); DA_PIN(sa); DA_PIN(sb); DA_DMA(1); DA_SBAR();
    fk1 = *(const __attribute__((address_space(3))) bf16x8*)(kq.a[3] + kslot + 0); sn0 = ATT_MFMA(fk2, qr[2], sn0); DA_PIN(sa); DA_PIN(sb); DA_SBAR();
    fk2 = *(const __attribute__((address_space(3))) bf16x8*)(kq.a[3] + kslot + 4096); sn1 = ATT_MFMA(fk0, qr[2], sn1); DA_PIN(sa); DA_PIN(sb); DA_DMA(2); DA_SBAR();
    sn0 = ATT_MFMA(fk1, qr[3], sn0); DA_PIN(sa); DA_PIN(sb); DA_SBAR();
    sn1 = ATT_MFMA(fk2, qr[3], sn1); DA_PIN(sa); DA_PIN(sb); DA_DMA(3); DA_SBAR();
    } else if constexpr (PV) {
    fl0 = vtr(vpt + 0); fh0 = vtr(vpt + 512); fl1 = vtr(vpt + 1024); fh1 = vtr(vpt + 1536); DA_SBAR();
    fl2 = vtr(vpt + 2048); fh2 = vtr(vpt + 2560); o[0] = ATT_MFMA(((bf16x8){fl0[0], fl0[1], fl0[2], fl0[3], fh0[0], fh0[1], fh0[2], fh0[3]}), __builtin_bit_cast(bf16x8, pwp[0]), o[0]); sc0[0] = __builtin_amdgcn_exp2f(sc0[0]); sc0[1] = __builtin_amdgcn_exp2f(sc0[1]); DA_PIN(sa); DA_PIN(sb); DA_PIN(sc0); DA_PIN(sc1); DA_SBAR();
    fl0 = vtr(vpt + 3072); fh0 = vtr(vpt + 3584); o[0] = ATT_MFMA(((bf16x8){fl1[0], fl1[1], fl1[2], fl1[3], fh1[0], fh1[1], fh1[2], fh1[3]}), __builtin_bit_cast(bf16x8, pwp[1]), o[0]); sc0[2] = __builtin_amdgcn_exp2f(sc0[2]); sc0[3] = __builtin_amdgcn_exp2f(sc0[3]); sa += sc0[0]; sb += sc0[1]; DA_PIN(sa); DA_PIN(sb); DA_PIN(sc0); DA_PIN(sc1); DA_SBAR();
    fl1 = vtr(vpt + 4096); fh1 = vtr(vpt + 4608); o[0] = ATT_MFMA(((bf16x8){fl2[0], fl2[1], fl2[2], fl2[3], fh2[0], fh2[1], fh2[2], fh2[3]}), __builtin_bit_cast(bf16x8, pwp[2]), o[0]); sc0[4] = __builtin_amdgcn_exp2f(sc0[4]); sc0[5] = __builtin_amdgcn_exp2f(sc0[5]); sa += sc0[2]; sb += sc0[3]; DA_PIN(sa); DA_PIN(sb); DA_PIN(sc0); DA_PIN(sc1); DA_SBAR();
    fl2 = vtr(vpt + 5120); fh2 = vtr(vpt + 5632); o[0] = ATT_MFMA(((bf16x8){fl0[0], fl0[1], fl0[2], fl0[3], fh0[0], fh0[1], fh0[2], fh0[3]}), __builtin_bit_cast(bf16x8, pwp[3]), o[0]); sc0[6] = __builtin_amdgcn_exp2f(sc0[6]); sc0[7] = __builtin_amdgcn_exp2f(sc0[7]); sa += sc0[4]; sb += sc0[5]; DA_PIN(sa); DA_PIN(sb); DA_PIN(sc0); DA_PIN(sc1); DA_SBAR();
    fl0 = vtr(vpt + 6144); fh0 = vtr(vpt + 6656); o[1] = ATT_MFMA(((bf16x8){fl1[0], fl1[1], fl1[2], fl1[3], fh1[0], fh1[1], fh1[2], fh1[3]}), __builtin_bit_cast(bf16x8, pwp[0]), o[1]); sc0[8] = __builtin_amdgcn_exp2f(sc0[8]); sc0[9] = __builtin_amdgcn_exp2f(sc0[9]); sa += sc0[6]; sb += sc0[7]; DA_PIN(sa); DA_PIN(sb); DA_PIN(sc0); DA_PIN(sc1); DA_SBAR();
    fl1 = vtr(vpt + 7168); fh1 = vtr(vpt + 7680); o[1] = ATT_MFMA(((bf16x8){fl2[0], fl2[1], fl2[2], fl2[3], fh2[0], fh2[1], fh2[2], fh2[3]}), __builtin_bit_cast(bf16x8, pwp[1]), o[1]); sc0[10] = __builtin_amdgcn_exp2f(sc0[10]); sc0[11] = __builtin_amdgcn_exp2f(sc0[11]); sa += sc0[8]; sb += sc0[9]; DA_PIN(sa); DA_PIN(sb); DA_PIN(sc0); DA_PIN(sc1); DA_SBAR();
    fl2 = vtr(vpt + 8192); fh2 = vtr(vpt + 8704); o[1] = ATT_MFMA(((bf16x8){fl0[0], fl0[1], fl0[2], fl0[3], fh0[0], fh0[1], fh0[2], fh0[3]}), __builtin_bit_cast(bf16x8, pwp[2]), o[1]); sc0[12] = __builtin_amdgcn_exp2f(sc0[12]); sc0[13] = __builtin_amdgcn_exp2f(sc0[13]); sa += sc0[10]; sb += sc0[11]; DA_PIN(sa); DA_PIN(sb); DA_PIN(sc0); DA_PIN(sc1); DA_SBAR();
    fl0 = vtr(vpt + 9216); fh0 = vtr(vpt + 9728); o[1] = ATT_MFMA(((bf16x8){fl1[0], fl1[1], fl1[2], fl1[3], fh1[0], fh1[1], fh1[2], fh1[3]}), __builtin_bit_cast(bf16x8, pwp[3]), o[1]); sc0[14] = __builtin_amdgcn_exp2f(sc0[14]); sc0[15] = __builtin_amdgcn_exp2f(sc0[15]); sa += sc0[12]; sb += sc0[13]; DA_PIN(sa); DA_PIN(sb); DA_PIN(sc0); DA_PIN(sc1); DA_SBAR();
    fl1 = vtr(vpt + 10240); fh1 = vtr(vpt + 10752); o[2] = ATT_MFMA(((bf16x8){fl2[0], fl2[1], fl2[2], fl2[3], fh2[0], fh2[1], fh2[2], fh2[3]}), __builtin_bit_cast(bf16x8, pwp[0]), o[2]); sc1[0] = __builtin_amdgcn_exp2f(sc1[0]); sc1[1] = __builtin_amdgcn_exp2f(sc1[1]); sa += sc0[14]; sb += sc0[15]; DA_PIN(sa); DA_PIN(sb); DA_PIN(sc0); DA_PIN(sc1); DA_SBAR();
    fl2 = vtr(vpt + 11264); fh2 = vtr(vpt + 11776); o[2] = ATT_MFMA(((bf16x8){fl0[0], fl0[1], fl0[2], fl0[3], fh0[0], fh0[1], fh0[2], fh0[3]}), __builtin_bit_cast(bf16x8, pwp[1]), o[2]); sc1[2] = __builtin_amdgcn_exp2f(sc1[2]); sc1[3] = __builtin_amdgcn_exp2f(sc1[3]); sa += sc1[0]; sb += sc1[1]; DA_PIN(sa); DA_PIN(sb); DA_PIN(sc0); DA_PIN(sc1); DA_SBAR();
    fl0 = vtr(vpt + 12288); fh0 = vtr(vpt + 12800); o[2] = ATT_MFMA(((bf16x8){fl1[0], fl1[1], fl1[2], fl1[3], fh1[0], fh1[1], fh1[2], fh1[3]}), __builtin_bit_cast(bf16x8, pwp[2]), o[2]); sc1[4] = __builtin_amdgcn_exp2f(sc1[4]); sc1[5] = __builtin_amdgcn_exp2f(sc1[5]); sa += sc1[2]; sb += sc1[3]; DA_PIN(sa); DA_PIN(sb); DA_PIN(sc0); DA_PIN(sc1); DA_SBAR();
    fl1 = vtr(vpt + 13312); fh1 = vtr(vpt + 13824); o[2] = ATT_MFMA(((bf16x8){fl2[0], fl2[1], fl2[2], fl2[3], fh2[0], fh2[1], fh2[2], fh2[3]}), __builtin_bit_cast(bf16x8, pwp[3]), o[2]); sc1[6] = __builtin_amdgcn_exp2f(sc1[6]); sc1[7] = __builtin_amdgcn_exp2f(sc1[7]); sa += sc1[4]; sb += sc1[5]; DA_PIN(sa); DA_PIN(sb); DA_PIN(sc0); DA_PIN(sc1); DA_SBAR();
    fl2 = vtr(vpt + 14336); fh2 = vtr(vpt + 14848); o[3] = ATT_MFMA(((bf16x8){fl0[0], fl0[1], fl0[2], fl0[3], fh0[0], fh0[1], fh0[2], fh0[3]}), __builtin_bit_cast(bf16x8, pwp[0]), o[3]); sc1[8] = __builtin_amdgcn_exp2f(sc1[8]); sc1[9] = __builtin_amdgcn_exp2f(sc1[9]); sa += sc1[6]; sb += sc1[7]; DA_PIN(sa); DA_PIN(sb); DA_PIN(sc0); DA_PIN(sc1); DA_SBAR();
    fl0 = vtr(vpt + 15360); fh0 = vtr(vpt + 15872); o[3] = ATT_MFMA(((bf16x8){fl1[0], fl1[1], fl1[2], fl1[3], fh1[0], fh1[1], fh1[2], fh1[3]}), __builtin_bit_cast(bf16x8, pwp[1]), o[3]); sc1[10] = __builtin_amdgcn_exp2f(sc1[10]); sc1[11] = __builtin_amdgcn_exp2f(sc1[11]); sa += sc1[8]; sb += sc1[9]; DA_PIN(sa); DA_PIN(sb); DA_PIN(sc0); DA_PIN(sc1); DA_SBAR();
    o[3] = ATT_MFMA(((bf16x8){fl2[0], fl2[1], fl2[2], fl2[3], fh2[0], fh2[1], fh2[2], fh2[3]}), __builtin_bit_cast(bf16x8, pwp[2]), o[3]); sc1[12] = __builtin_amdgcn_exp2f(sc1[12]); sc1[13] = __builtin_amdgcn_exp2f(sc1[13]); sa += sc1[10]; sb += sc1[11]; DA_PIN(sa); DA_PIN(sb); DA_PIN(sc0); DA_PIN(sc1); DA_SBAR();
    o[3] = ATT_MFMA(((bf16x8){fl0[0], fl0[1], fl0[2], fl0[3], fh0[0], fh0[1], fh0[2], fh0[3]}), __builtin_bit_cast(bf16x8, pwp[3]), o[3]); sc1[14] = __builtin_amdgcn_exp2f(sc1[14]); sc1[15] = __builtin_amdgcn_exp2f(sc1[15]); sa += sc1[12]; sb += sc1[13]; DA_PIN(sa); DA_PIN(sb); DA_PIN(sc0); DA_PIN(sc1); DA_SBAR();
    sa += sc1[14]; sb += sc1[15]; pwc[0][0] = cvtpk(sc0[0], sc0[1]); pwc[0][1] = cvtpk(sc0[2], sc0[3]); DA_PIN(pwc[0]); pwc[0][2] = cvtpk(sc0[4], sc0[5]); pwc[0][3] = cvtpk(sc0[6], sc0[7]); DA_PIN(pwc[0]); DA_PIN(sa); DA_PIN(sb); DA_SBAR();
    pwc[1][0] = cvtpk(sc0[8], sc0[9]); pwc[1][1] = cvtpk(sc0[10], sc0[11]); DA_PIN(pwc[1]); pwc[1][2] = cvtpk(sc0[12], sc0[13]); pwc[1][3] = cvtpk(sc0[14], sc0[15]); DA_PIN(pwc[1]); DA_PIN(sa); DA_PIN(sb); DA_SBAR();
    pwc[2][0] = cvtpk(sc1[0], sc1[1]); pwc[2][1] = cvtpk(sc1[2], sc1[3]); DA_PIN(pwc[2]); pwc[2][2] = cvtpk(sc1[4], sc1[5]); pwc[2][3] = cvtpk(sc1[6], sc1[7]); DA_PIN(pwc[2]); DA_PIN(sa); DA_PIN(sb); DA_SBAR();
    pwc[3][0] = cvtpk(sc1[8], sc1[9]); pwc[3][1] = cvtpk(sc1[10], sc1[11]); DA_PIN(pwc[3]); pwc[3][2] = cvtpk(sc1[12], sc1[13]); pwc[3][3] = cvtpk(sc1[14], sc1[15]); DA_PIN(pwc[3]); DA_PIN(sa); DA_PIN(sb); DA_SBAR();
    } else {
    fk0 = *(const __attribute__((address_space(3))) bf16x8*)(kq.a[0] + kslot + 0); fk1 = *(const __attribute__((address_space(3))) bf16x8*)(kq.a[0] + kslot + 4096); DA_SBAR();
    fk2 = *(const __attribute__((address_space(3))) bf16x8*)(kq.a[1] + kslot + 0); sn0 = ATT_MFMA(fk0, qr[0], ci); sc0[0] = __builtin_amdgcn_exp2f(sc0[0]); sc0[1] = __builtin_amdgcn_exp2f(sc0[1]); sc0[2] = __builtin_amdgcn_exp2f(sc0[2]); sc0[3] = __builtin_amdgcn_exp2f(sc0[3]); DA_PIN(sa); DA_PIN(sb); DA_PIN(sc0); DA_PIN(sc1); DA_SBAR();
    fk0 = *(const __attribute__((address_space(3))) bf16x8*)(kq.a[1] + kslot + 4096); sn1 = ATT_MFMA(fk1, qr[0], ci); sc0[4] = __builtin_amdgcn_exp2f(sc0[4]); sc0[5] = __builtin_amdgcn_exp2f(sc0[5]); sc0[6] = __builtin_amdgcn_exp2f(sc0[6]); sc0[7] = __builtin_amdgcn_exp2f(sc0[7]); sa += sc0[0]; sb += sc0[1]; sa += sc0[2]; sb += sc0[3]; DA_PIN(sa); DA_PIN(sb); DA_PIN(sc0); DA_PIN(sc1); DA_SBAR();
    fk1 = *(const __attribute__((address_space(3))) bf16x8*)(kq.a[2] + kslot + 0); sn0 = ATT_MFMA(fk2, qr[1], sn0); sc0[8] = __builtin_amdgcn_exp2f(sc0[8]); sc0[9] = __builtin_amdgcn_exp2f(sc0[9]); sc0[10] = __builtin_amdgcn_exp2f(sc0[10]); sc0[11] = __builtin_amdgcn_exp2f(sc0[11]); sa += sc0[4]; sb += sc0[5]; sa += sc0[6]; sb += sc0[7]; DA_PIN(sa); DA_PIN(sb); DA_PIN(sc0); DA_PIN(sc1); DA_SBAR();
    fk2 = *(const __attribute__((address_space(3))) bf16x8*)(kq.a[2] + kslot + 4096); sn1 = ATT_MFMA(fk0, qr[1], sn1); sc0[12] = __builtin_amdgcn_exp2f(sc0[12]); sc0[13] = __builtin_amdgcn_exp2f(sc0[13]); sc0[14] = __builtin_amdgcn_exp2f(sc0[14]); sc0[15] = __builtin_amdgcn_exp2f(sc0[15]); sa += sc0[8]; sb += sc0[9]; sa += sc0[10]; sb += sc0[11]; DA_PIN(sa); DA_PIN(sb); DA_PIN(sc0); DA_PIN(sc1); DA_SBAR();
    fk0 = *(const __attribute__((address_space(3))) bf16x8*)(kq.a[3] + kslot + 0); sn0 = ATT_MFMA(fk1, qr[2], sn0); sc1[0] = __builtin_amdgcn_exp2f(sc1[0]); sc1[1] = __builtin_amdgcn_exp2f(sc1[1]); sc1[2] = __builtin_amdgcn_exp2f(sc1[2]); sc1[3] = __builtin_amdgcn_exp2f(sc1[3]); sa += sc0[12]; sb += sc0[13]; sa += sc0[14]; sb += sc0[15]; DA_PIN(sa); DA_PIN(sb); DA_PIN(sc0); DA_PIN(sc1); DA_SBAR();
    fk1 = *(const __attribute__((address_space(3))) bf16x8*)(kq.a[3] + kslot + 4096); sn1 = ATT_MFMA(fk2, qr[2], sn1); sc1[4] = __builtin_amdgcn_exp2f(sc1[4]); sc1[5] = __builtin_amdgcn_exp2f(sc1[5]); sc1[6] = __builtin_amdgcn_exp2f(sc1[6]); sc1[7] = __builtin_amdgcn_exp2f(sc1[7]); sa += sc1[0]; sb += sc1[1]; sa += sc1[2]; sb += sc1[3]; DA_PIN(sa); DA_PIN(sb); DA_PIN(sc0); DA_PIN(sc1); DA_SBAR();
    sn0 = ATT_MFMA(fk0, qr[3], sn0); sc1[8] = __builtin_amdgcn_exp2f(sc1[8]); sc1[9] = __builtin_amdgcn_exp2f(sc1[9]); sc1[10] = __builtin_amdgcn_exp2f(sc1[10]); sc1[11] = __builtin_amdgcn_exp2f(sc1[11]); sa += sc1[4]; sb += sc1[5]; sa += sc1[6]; sb += sc1[7]; DA_PIN(sa); DA_PIN(sb); DA_PIN(sc0); DA_PIN(sc1); DA_SBAR();
    sn1 = ATT_MFMA(fk1, qr[3], sn1); sc1[12] = __builtin_amdgcn_exp2f(sc1[12]); sc1[13] = __builtin_amdgcn_exp2f(sc1[13]); sc1[14] = __builtin_amdgcn_exp2f(sc1[14]); sc1[15] = __builtin_amdgcn_exp2f(sc1[15]); sa += sc1[8]; sb += sc1[9]; sa += sc1[10]; sb += sc1[11]; DA_PIN(sa); DA_PIN(sb); DA_PIN(sc0); DA_PIN(sc1); DA_SBAR();
    sa += sc1[12]; sb += sc1[13]; sa += sc1[14]; sb += sc1[15]; pwc[0][0] = cvtpk(sc0[0], sc0[1]); pwc[0][1] = cvtpk(sc0[2], sc0[3]); DA_PIN(pwc[0]); pwc[0][2] = cvtpk(sc0[4], sc0[5]); pwc[0][3] = cvtpk(sc0[6], sc0[7]); DA_PIN(pwc[0]); DA_PIN(sa); DA_PIN(sb); DA_SBAR();
    pwc[1][0] = cvtpk(sc0[8], sc0[9]); pwc[1][1] = cvtpk(sc0[10], sc0[11]); DA_PIN(pwc[1]); pwc[1][2] = cvtpk(sc0[12], sc0[13]); pwc[1][3] = cvtpk(sc0[14], sc0[15]); DA_PIN(pwc[1]); DA_PIN(sa); DA_PIN(sb); DA_SBAR();
    pwc[2][0] = cvtpk(sc1[0], sc1[1]); pwc[2][1] = cvtpk(sc1[2], sc1[3]); DA_PIN(pwc[2]); pwc[2][2] = cvtpk(sc1[4], sc1[5]); pwc[2][3] = cvtpk(sc1[6], sc1[7]); DA_PIN(pwc[2]); DA_PIN(sa); DA_PIN(sb); DA_SBAR();
    pwc[3][0] = cvtpk(sc1[8], sc1[9]); pwc[3][1] = cvtpk(sc1[10], sc1[11]); DA_PIN(pwc[3]); pwc[3][2] = cvtpk(sc1[12], sc1[13]); pwc[3][3] = cvtpk(sc1[14], sc1[15]); DA_PIN(pwc[3]); DA_PIN(sa); DA_PIN(sb); DA_SBAR();
    }
#undef DA_DMA
    l += sa + sb;
    if (!FIRST && PV && resc) {
#pragma unroll
        for (int db = 0; db < 4; ++db)
#pragma unroll
            for (int r = 0; r < 16; ++r) o[db][r] *= f;
    }
}
template <bool ONLINE> __device__ __forceinline__ void da_unit(int b, int h, int qb, const bf16* __restrict__ PROJ, bf16* __restrict__ MIX, char* shm, const Tabs& T) {
    const int tid = threadIdx.x; int lane = tid & 63; asm volatile("" : "+v"(lane));
    const int r32 = lane & 31, hi = lane >> 5; const int wid = __builtin_amdgcn_readfirstlane(tid >> 6);
    const int map = wid >> 2, wq = wid & 3;
    const long rowbase = (long)b * SEQ; const int q0 = qb * 128;
    const unsigned lds0 = (unsigned)(uintptr_t)shm;
    const lds_cptr shm3 = (lds_cptr)shm;
    const bf16* Qw = proj_slab(PROJ, C_DQ / 64 + 2 * h + map, b) + (q0 + wq * 32 + r32) * 64;
    bf16x8 qr[4];
#pragma unroll
    for (int d0 = 0; d0 < 4; ++d0) qr[d0] = *reinterpret_cast<const bf16x8*>(Qw + d0 * 16 + hi * 8);
    const unsigned kvoff = (unsigned)(((8 * wid + (lane >> 3)) * 64 + (((lane & 7) ^ ((4 * wid + (lane >> 4)) & 7)) << 3)) * 2);
    const unsigned vvoff = (unsigned)(((16 * (wid & 3) + (lane >> 2)) * 64 + (wid >> 2) * 32 + (lane & 3) * 8) * 2);
    const char* kbase = (const char*)proj_slab(PROJ, C_DK / 64 + 2 * h, b); const char* vbase = (const char*)proj_slab(PROJ, C_DV / 64 + 2 * h, b);
    const unsigned kdst = lds0 + wid * 1024, vdst = lds0 + DA_VBASE + wid * 1024;
    const int NT = 2 * qb + 2;
#define DA_ISSUE_K(t) do { if ((t) < NT) { const char* _b = kbase + (long)(t) * TILEB; const unsigned _s = (unsigned)(((t) & 3) * DA_KSLOT); \
        glds16s<0>(kvoff, _b, (unsigned)__builtin_amdgcn_readfirstlane(kdst + _s)); glds16s<0>(kvoff, _b + GRPB, (unsigned)__builtin_amdgcn_readfirstlane(kdst + 8192 + _s)); } } while (0)
#define DA_ISSUE_V(t) do { if ((t) < NT) { const char* _b = vbase + (long)(t) * TILEB; const unsigned _s = (unsigned)(((t) & 3) * DA_VSLOT); \
        glds16s<0>(vvoff, _b, (unsigned)__builtin_amdgcn_readfirstlane(vdst + _s)); glds16s<0>(vvoff, _b + GRPB, (unsigned)__builtin_amdgcn_readfirstlane(vdst + 8192 + _s)); } } while (0)
    DA_ISSUE_K(0); DA_ISSUE_K(1); DA_ISSUE_V(0); DA_ISSUE_K(2); DA_ISSUE_V(1);
    DaCtx C; C.kq = kq_make(shm3 + map * 8192, r32, hi);
    C.vp0 = shm3 + DA_VBASE + ((lane >> 4) & 1) * 32 + (lane & 3) * 8 + (4 * hi + ((lane & 15) >> 2)) * 64;
    C.bt = T.btab + h * 256; C.NT = NT; C.kvoff = kvoff; C.vvoff = vvoff; C.kdst = kdst; C.vdst = vdst; C.kbase = kbase; C.vbase = vbase; C.cq = 2 * qb + (wq >> 1); C.qpos = q0 + wq * 32 + r32; C.hi = hi;
    float mhat = 0.f, l = 0.f; f32x16 o[4]; o[0] = f32x16{}; o[1] = f32x16{}; o[2] = f32x16{}; o[3] = f32x16{};
    f32x16 sA0 = f32x16{}, sA1 = f32x16{}, sB0 = f32x16{}, sB1 = f32x16{}; u32x4 pA[4], pB[4];
#pragma unroll
    for (int k = 0; k < 4; ++k) { pA[k] = u32x4{}; pB[k] = u32x4{}; }
    if (NT >= 3) { ATT_WAIT_BAR(8); } else { ATT_WAIT_BAR(6); }
    qkt(sA0, sA1, C.kq, 0, qr);
    if (NT >= 3) { ATT_WAIT_BAR(6); } else { ATT_WAIT_BAR(0); }
#define DA_END(t) do { if ((t) + 3 < NT) { ATT_WAIT_BAR(6); } else { ATT_WAIT_BAR(0); } } while (0)
#define DA_STEP_BEGIN(t) do { DA_ISSUE_K((t) + 3); DA_ISSUE_V((t) + 2); } while (0)
    int t = 0;
    if (C.cq == 0) {
        DA_STEP_BEGIN(0); da_step_plain<ONLINE>(0, sA0, sA1, sB0, sB1, pB, pA, o, mhat, l, qr, C); DA_END(0);
        DA_STEP_BEGIN(1); pv<4>(o, C.vp0, pA); DA_END(1);
    } else if (C.cq & 1) {
        DA_STEP_BEGIN(0); da_step_hot<false, true, true, ONLINE>(0, sA0, sA1, sB0, sB1, pB, pA, o, mhat, l, qr, C); DA_END(0);
        for (t = 1; t + 1 < C.cq; t += 2) {
            da_step_hot<true, true, false, ONLINE>(t, sB0, sB1, sA0, sA1, pA, pB, o, mhat, l, qr, C); DA_END(t);
            da_step_hot<true, true, false, ONLINE>(t + 1, sA0, sA1, sB0, sB1, pB, pA, o, mhat, l, qr, C); DA_END(t + 1);
        }
        const int tl = C.cq;
        DA_STEP_BEGIN(tl); da_step_hot<true, false, false, ONLINE>(tl, sB0, sB1, sA0, sA1, pA, pB, o, mhat, l, qr, C); DA_END(tl);
        pv<4>(o, C.vp0 + (tl & 3) * DA_VSLOT, pB);
    } else {
        DA_STEP_BEGIN(0); da_step_hot<false, true, true, ONLINE>(0, sA0, sA1, sB0, sB1, pB, pA, o, mhat, l, qr, C); DA_END(0);
        for (t = 1; t + 2 < C.cq; t += 2) {
            da_step_hot<true, true, false, ONLINE>(t, sB0, sB1, sA0, sA1, pA, pB, o, mhat, l, qr, C); DA_END(t);
            da_step_hot<true, true, false, ONLINE>(t + 1, sA0, sA1, sB0, sB1, pB, pA, o, mhat, l, qr, C); DA_END(t + 1);
        }
        const int t1 = C.cq - 1;
        da_step_hot<true, true, false, ONLINE>(t1, sB0, sB1, sA0, sA1, pA, pB, o, mhat, l, qr, C); DA_END(t1);
        DA_STEP_BEGIN(t1 + 1); da_step_hot<true, false, false, ONLINE>(t1 + 1, sA0, sA1, sB0, sB1, pB, pA, o, mhat, l, qr, C); DA_END(t1 + 1);
        DA_STEP_BEGIN(t1 + 2); pv<4>(o, C.vp0 + ((t1 + 1) & 3) * DA_VSLOT, pA); DA_END(t1 + 2);
    }
#undef DA_STEP_BEGIN
    ATT_LBAR();
#undef DA_END
    const float linv = 1.0f / swap_sum(l);
    __attribute__((address_space(3))) float* xch = (__attribute__((address_space(3))) float*)(shm3 + DA_XCH) + wq * 4096;
    if (map == 1) {
#pragma unroll
        for (int db = 0; db < 4; ++db) {
#pragma unroll
            for (int r = 0; r < 16; ++r) xch[(db * 16 + r) * 64 + lane] = o[db][r] * linv;
            __builtin_amdgcn_sched_barrier(0); }
    }
    ATT_LBAR();
    if (map == 0) {
        float ss = 0.f;
#pragma unroll
        for (int db = 0; db < 4; ++db) {
#pragma unroll
            for (int r = 0; r < 16; ++r) { const float v = o[db][r] * linv - T.lam * xch[(db * 16 + r) * 64 + lane]; o[db][r] = v; ss += v * v; }
            __builtin_amdgcn_sched_barrier(0); }
        ss = swap_sum(ss);
        const float rn = __builtin_amdgcn_rsqf(ss * (1.0f / 128.0f) + 1e-6f);
        lds_ptr stg = (lds_ptr)shm3 + DA_STG + wq * (32 * DA_STG_ROW);
        lds_ptr stg_l = stg + r32 * DA_STG_ROW + 8 * hi; const __attribute__((address_space(3))) float* gsub_l = T.gsub + 4 * hi;
#pragma unroll
        for (int db = 0; db < 4; ++db) {
#pragma unroll
            for (int g4 = 0; g4 < 4; ++g4) { const int dc = 32 * db + 8 * g4; const int r = 4 * g4;
                const f32x4v gg = *(const __attribute__((address_space(3))) f32x4v*)(gsub_l + dc);
                u32x2 w; w.x = cvtpk(o[db][r] * rn * gg[0], o[db][r + 1] * rn * gg[1]); w.y = cvtpk(o[db][r + 2] * rn * gg[2], o[db][r + 3] * rn * gg[3]);
                *(__attribute__((address_space(3))) u32x2*)(stg_l + dc * 2) = w; }
            __builtin_amdgcn_sched_barrier(0); }
        asm volatile("s_waitcnt lgkmcnt(0)" ::: "memory");
        bf16* Mw = MIX + (rowbase + q0 + wq * 32) * MIXP + h * 128;
#pragma unroll
        for (int i = 0; i < 8; ++i) { const int row = i * 4 + (lane >> 4), ch = lane & 15; const u32x4 v = *(const __attribute__((address_space(3))) u32x4*)(stg + row * DA_STG_ROW + ch * 16);
            __builtin_nontemporal_store(v, (u32x4*)(Mw + (long)row * MIXP + ch * 8)); }
    }
    ATT_LBAR();
#undef DA_ISSUE_K
#undef DA_ISSUE_V
}

constexpr int SB_SLOT = 16384, SB_HEAD = 65536, SB_STG = 0, SB_STG_ROW = 144, SB_FLAG = 8 * 32 * 144;
constexpr float SB_EPS = 1e-12f;
__device__ __forceinline__ void sb_unit(int b, int hp, int qb, const bf16* __restrict__ PROJ, bf16* __restrict__ MIX, char* shm, const Tabs& T) {
    const int tid = threadIdx.x; int lane = tid & 63; asm volatile("" : "+v"(lane));
    const int r32 = lane & 31, hi = lane >> 5; const int wid = __builtin_amdgcn_readfirstlane(tid >> 6);
    const int hsel = wid >> 2, wq = wid & 3, h = 2 * hp + hsel;
    const long rowbase = (long)b * SEQ; const int q0 = qb * 128;
    const unsigned lds0 = (unsigned)(uintptr_t)shm + hsel * SB_HEAD;
    const lds_cptr shm3 = (lds_cptr)shm;
    const unsigned kvoff = (unsigned)(((8 * wq + (lane >> 3)) * 64 + (((lane & 7) ^ ((4 * wq + (lane >> 4)) & 7)) << 3)) * 2);
    const unsigned vvoff = (unsigned)(((16 * wq + (lane >> 2)) * 64 + (lane & 3) * 8) * 2);
    const char* kbase = (const char*)proj_slab(PROJ, C_SK / 64 + h, b); const char* vbase = (const char*)proj_slab(PROJ, C_SV / 64 + h, b);
    const unsigned kdst = lds0 + wq * 1024, vdst = lds0 + 8192 + wq * 1024;
#define SB_ISSUE(t, slot) do { const long _o = (long)(t) * TILEB; const unsigned _s = (unsigned)(slot); \
        glds16s<0>(kvoff, kbase + _o, (unsigned)__builtin_amdgcn_readfirstlane(kdst + _s)); glds16s<0>(kvoff, kbase + _o + 32 * 128, (unsigned)__builtin_amdgcn_readfirstlane(kdst + 4096 + _s)); \
        glds16s<0>(vvoff, vbase + _o, (unsigned)__builtin_amdgcn_readfirstlane(vdst + _s)); glds16s<64>(vvoff, vbase + _o, (unsigned)__builtin_amdgcn_readfirstlane(vdst + 4096 - 64 + _s)); } while (0)
    const int TTOP = 2 * qb + 1;
#pragma unroll
    for (int i = 0; i < 4; ++i) if (TTOP - i >= 0) SB_ISSUE(TTOP - i, i * SB_SLOT);
    const bf16* Qw = proj_slab(PROJ, C_SQ / 64 + h, b) + (q0 + wq * 32 + r32) * 64;
    bf16x8 qr[4];
#pragma unroll
    for (int d0 = 0; d0 < 4; ++d0) qr[d0] = *reinterpret_cast<const bf16x8*>(Qw + d0 * 16 + hi * 8);
    const KQ kq = kq_make(shm3 + hsel * SB_HEAD, r32, hi);
    const lds_cptr vp0 = shm3 + hsel * SB_HEAD + 8192 + ((lane >> 4) & 1) * 32 + (lane & 3) * 8 + (4 * hi + ((lane & 15) >> 2)) * 64;
    const int td = 2 * qb + (wq >> 1);
    const int qpos = q0 + wq * 32 + r32;
    volatile __attribute__((address_space(3))) unsigned* flags = (volatile __attribute__((address_space(3))) unsigned*)(shm3 + 131072 + 448);
    float R = 1.0f; bool done = false; f32x16 o[2]; o[0] = f32x16{}; o[1] = f32x16{};
    int it = 0;
    for (int t = TTOP; t >= 0; --t, ++it) {
        const int slot = (it & 3) * SB_SLOT;
        { const int ahead = t < 3 ? t : 3;
          if (ahead == 3) { ATT_WAIT_BAR(12); } else if (ahead == 2) { ATT_WAIT_BAR(8); } else if (ahead == 1) { ATT_WAIT_BAR(4); } else { ATT_WAIT_BAR(0); } }
        if (t <= td && !done) {
            f32x16 z0, z1;
            qkt(z0, z1, kq, slot, qr);
            f32x16 om0, om1;
#pragma unroll
            for (int r = 0; r < 16; ++r) {
                const float e0 = __builtin_amdgcn_exp2f(fminf(z0[r], 100.f)), e1 = __builtin_amdgcn_exp2f(fminf(z1[r], 100.f));
                om0[r] = __builtin_amdgcn_rcpf(1.0f + e0); om1[r] = __builtin_amdgcn_rcpf(1.0f + e1); z0[r] = e0 * om0[r]; z1[r] = e1 * om1[r]; }
            if (t == td) {
                const int kb = 64 * t + 4 * hi;
#pragma unroll
                for (int r = 0; r < 16; ++r) { const int kv = kb + (r & 3) + 8 * (r >> 2);
                    if (kv >= qpos) { om0[r] = 1.f; z0[r] = 0.f; } if (kv + 32 >= qpos) { om1[r] = 1.f; z1[r] = 0.f; } }
            }
#define SB_GROUP(OM, BE, g4) do { const float c01 = OM[4 * g4] * OM[4 * g4 + 1], c23 = OM[4 * g4 + 2] * OM[4 * g4 + 3]; const float c = c01 * c23; \
            auto rr = __builtin_amdgcn_permlane32_swap(__float_as_uint(c), __float_as_uint(c), false, false); const float clo = __uint_as_float(rr[0]), chi = __uint_as_float(rr[1]); \
            const float t1 = R * chi; const float S = hi ? R : t1; R = t1 * clo; \
            const float w2 = S * OM[4 * g4 + 3], w1 = w2 * OM[4 * g4 + 2], w0 = w1 * OM[4 * g4 + 1]; \
            BE[4 * g4 + 3] *= S; BE[4 * g4 + 2] *= w2; BE[4 * g4 + 1] *= w1; BE[4 * g4] *= w0; } while (0)
            SB_GROUP(om1, z1, 3); SB_GROUP(om1, z1, 2); SB_GROUP(om1, z1, 1); SB_GROUP(om1, z1, 0);
            SB_GROUP(om0, z0, 3); SB_GROUP(om0, z0, 2); SB_GROUP(om0, z0, 1); SB_GROUP(om0, z0, 0);
#undef SB_GROUP
            u32x4 pw[4]; pack_p(pw, z0, z1);
            pv<2>(o, vp0 + slot, pw);
            done = __all(R < SB_EPS);
        }
        if (lane == 0) flags[wid] = done ? 1u : 0u;
        ATT_LBAR();
        unsigned alld = 1u;
#pragma unroll
        for (int w = 0; w < 8; ++w) alld &= flags[w];
        if (__builtin_amdgcn_readfirstlane(alld)) break;
        if (t - 4 >= 0) SB_ISSUE(t - 4, slot);
    }
    ATT_WAIT_BAR(0);
    {
        float ss = 0.f;
#pragma unroll
        for (int db = 0; db < 2; ++db)
#pragma unroll
            for (int r = 0; r < 16; ++r) ss += o[db][r] * o[db][r];
        ss = swap_sum(ss);
        const float rn = __builtin_amdgcn_rsqf(ss * (1.0f / 64.0f) + 1e-6f);
        lds_ptr stg = (lds_ptr)shm3 + SB_STG + wid * (32 * SB_STG_ROW);
        lds_ptr stg_l = stg + r32 * SB_STG_ROW + 8 * hi; const __attribute__((address_space(3))) float* gsb_l = T.gsb + 4 * hi;
#pragma unroll
        for (int db = 0; db < 2; ++db)
#pragma unroll
            for (int g4 = 0; g4 < 4; ++g4) { const int dc = 32 * db + 8 * g4; const int r = 4 * g4;
                const f32x4v gg = *(const __attribute__((address_space(3))) f32x4v*)(gsb_l + dc);
                u32x2 w; w.x = cvtpk(o[db][r] * rn * gg[0], o[db][r + 1] * rn * gg[1]); w.y = cvtpk(o[db][r + 2] * rn * gg[2], o[db][r + 3] * rn * gg[3]);
                *(__attribute__((address_space(3))) u32x2*)(stg_l + dc * 2) = w; }
        asm volatile("s_waitcnt lgkmcnt(0)" ::: "memory");
        bf16* Mw = MIX + (rowbase + q0 + wq * 32) * MIXP + 512 + h * 64;
#pragma unroll
        for (int i = 0; i < 4; ++i) { const int row = i * 8 + (lane >> 3), ch = lane & 7; const u32x4 v = *(const __attribute__((address_space(3))) u32x4*)(stg + row * SB_STG_ROW + ch * 16);
            __builtin_nontemporal_store(v, (u32x4*)(Mw + (long)row * MIXP + ch * 8)); }
    }
    ATT_LBAR();
#undef SB_ISSUE
}
}
constexpr int NWAVES = 8;
#ifndef MK_N_LAUNCHES
#define MK_N_LAUNCHES 1
#endif
constexpr int N_PHASES = 9;
constexpr int BATCH = 4, SEQ = 8192, D = 1024, NTOK = BATCH * SEQ;
constexpr int INW = 3072, NEXP = 32, EH = 512, ECAP = 32768;
constexpr int MAXBLK = 288;
constexpr float EPS = 1e-6f;
constexpr float LAMBDA_INIT = 0.2f;

constexpr size_t MiB = 1u << 20;
constexpr size_t WS_CTL = 0, CTL_ZERO_BYTES = 1 * MiB;
constexpr size_t WS_WIN = 2 * MiB, WS_WO = 8 * MiB, WS_W13 = 10 * MiB, WS_W2 = 74 * MiB, WS_RF = 106 * MiB;
constexpr size_t WS_XN = 108 * MiB;
constexpr size_t WS_PROJ = 172 * MiB;
constexpr size_t WS_U = 172 * MiB, WS_HID = 236 * MiB, WS_X1F8 = 272 * MiB  , WS_TOKS = 308 * MiB, WS_GATES = 312 * MiB, WS_RNS = 316 * MiB, WS_REC = 320 * MiB;
constexpr size_t WS_YS = 364 * MiB, WS_END = 508 * MiB;
constexpr int CW_TMO = 0, CW_BAR = 4096, CW_Q = 8192, CW_CNT = 12288, CW_DONE = 16384  ;
constexpr int RING_OFF = 0, RING_BYTES = 131072;
constexpr int LDSCTL_OFF = RING_BYTES, MISC_OFF = LDSCTL_OFF + 320;
constexpr int TAB_OFF = RING_BYTES + 512;
constexpr int MOE_OFF = TAB_OFF + 4864;
constexpr int LDS_BYTES = 147456;
static_assert(MOE_OFF + 3 * MAXBLK * 4 + 16 <= LDS_BYTES, "LDS map");

#define GAS __attribute__((address_space(1)))
#define LAS __attribute__((address_space(3)))
typedef unsigned short bf16;
typedef unsigned v4u __attribute__((ext_vector_type(4)));
typedef unsigned v2u __attribute__((ext_vector_type(2)));
typedef float f32x4 __attribute__((ext_vector_type(4)));
typedef short bf16x8 __attribute__((ext_vector_type(8)));
typedef GAS unsigned gu32;
#define RLX_AGENT __ATOMIC_RELAXED, __HIP_MEMORY_SCOPE_AGENT
#define LDS_WAIT() asm volatile("s_waitcnt lgkmcnt(0)" ::: "memory")
#define VM_WAIT() asm volatile("s_waitcnt vmcnt(0)" ::: "memory")
__device__ __forceinline__ unsigned f2bf(float f) { unsigned u = __builtin_bit_cast(unsigned, f); return (u + 0x7fffu + ((u >> 16) & 1u)) >> 16; }
__device__ __forceinline__ unsigned pk2(float lo, float hi) { return f2bf(lo) | (f2bf(hi) << 16); }
__device__ __forceinline__ float bf2f(unsigned h) { return __builtin_bit_cast(float, h << 16); }
__device__ __forceinline__ float clamp448(float v) { return __builtin_amdgcn_fmed3f(v, -448.f, 448.f); }
__device__ __forceinline__ unsigned pk4_fp8(float a, float b, float c, float d) { int w = 0; w = __builtin_amdgcn_cvt_pk_fp8_f32(a, b, w, false); w = __builtin_amdgcn_cvt_pk_fp8_f32(c, d, w, true); return (unsigned)w; }
constexpr float W13_SCALE = 64.f, W2_SCALE = 32.f;

#define XB_TMO      128
#define XB_XCNT(j)  (256  + 64 * (j))
#define XB_XSUB(j)  (1280 + 64 * (j))
#define XB_XGEN(j)  (2304 + 64 * (j))
#define XB_TOP      3328
#define XB_TOPGEN   3392
#define XCD_BAR_WORDS 3456
#define XB_SPIN_CAP (1u << 18)
__device__ __forceinline__ unsigned xb_ld(unsigned* p)              { return __hip_atomic_load(p, __ATOMIC_RELAXED, __HIP_MEMORY_SCOPE_AGENT); }
__device__ __forceinline__ unsigned xb_add(unsigned* p, unsigned v) { return __hip_atomic_fetch_add(p, v, __ATOMIC_RELAXED, __HIP_MEMORY_SCOPE_AGENT); }
__device__ __forceinline__ unsigned xb_xcc_id() { return (unsigned)__builtin_amdgcn_s_getreg((3 << 11) | 20) & 0xFu; }
#define XB_SPIN(cond, bar) do { unsigned _sp = 0; while (cond) { __builtin_amdgcn_s_sleep(1); \
    if ((++_sp & 255u) == 0u) { if (xb_ld(&(bar)[XB_TMO])) break; if (_sp > XB_SPIN_CAP) { atomicAdd(&(bar)[XB_TMO], 1u); break; } } } } while (0)
struct XcdBarrier { unsigned* bar; unsigned x; volatile LAS unsigned* st; };
__device__ __forceinline__ XcdBarrier xcd_barrier_post(unsigned* bar, volatile LAS unsigned* st) {
    XcdBarrier b; b.bar = bar; b.x = xb_xcc_id(); b.st = st;
    if (threadIdx.x == 0) st[4] = xb_add(&bar[XB_XCNT(b.x)], 1u);
    return b;
}
__device__ __forceinline__ void xcd_barrier_complete(unsigned* bar, unsigned x, unsigned& nloc, unsigned& nx) {
    const unsigned G = gridDim.x * gridDim.y * gridDim.z;
    unsigned sum, cnt, mine, sp = 0u;
    for (;;) {
        sum = 0u; cnt = 0u; mine = 0u;
#pragma unroll
        for (unsigned j = 0; j < 16; ++j) { const unsigned c = xb_ld(&bar[XB_XCNT(j)]); sum += c; cnt += (c > 0u) ? 1u : 0u; mine = (j == x) ? c : mine; }
        if (sum == G) break;
        __builtin_amdgcn_s_sleep(1);
        if ((++sp & 255u) == 0u) { if (xb_ld(&bar[XB_TMO])) break; if (sp > XB_SPIN_CAP) { atomicAdd(&bar[XB_TMO], 1u); break; } }
    }
    nloc = mine > 0u ? mine : 1u; nx = cnt > 0u ? cnt : 1u;
}
__device__ __forceinline__ void xcd_barrier(const XcdBarrier& b) {
    asm volatile("s_waitcnt vmcnt(0)" ::: "memory");
    __syncthreads();
    if (threadIdx.x == 0) {
        unsigned* bar = b.bar;
        __builtin_amdgcn_s_waitcnt(0);
        unsigned nloc = b.st[0], nx = b.st[1];
        if (nloc == 0u) { xcd_barrier_complete(bar, b.x, nloc, nx); b.st[0] = nloc; b.st[1] = nx; }
        const unsigned old = xb_add(&bar[XB_XSUB(b.x)], 1u);
        const unsigned gen = old / nloc;
        if (old + 1u == (gen + 1u) * nloc) {
            __builtin_amdgcn_fence(__ATOMIC_RELEASE, "agent");
            asm volatile("s_waitcnt vmcnt(0)" ::: "memory");
            const unsigned og = xb_add(&bar[XB_TOP], 1u);
            const unsigned tg = og / nx;
            if (og + 1u == (tg + 1u) * nx) xb_add(&bar[XB_TOPGEN], 1u);
            else XB_SPIN(xb_ld(&bar[XB_TOPGEN]) == tg, bar);
            __builtin_amdgcn_fence(__ATOMIC_ACQUIRE, "agent");
            xb_add(&bar[XB_XGEN(b.x)], 1u);
            asm volatile("s_waitcnt vmcnt(0)" ::: "memory");
        } else {
            XB_SPIN(xb_ld(&bar[XB_XGEN(b.x)]) == gen, bar);
            __builtin_amdgcn_fence(__ATOMIC_ACQUIRE, "agent");
            asm volatile("s_waitcnt vmcnt(0)" ::: "memory");
        }
    }
    __syncthreads();
}

struct Args { const float* in[21]; float* out; unsigned char* ws; int ph_lo, ph_hi, rep1, pad; };
struct Frame {
    LAS unsigned char* lds;
    volatile LAS unsigned* MISC;
    gu32* ctl;
    int tid, lane, wave;
    int vcu, G;
    const Args* A;
};
enum { I_X = 0, I_GATTN, I_WIN, I_QNG, I_KNG, I_LQ1, I_LK1, I_LQ2, I_LK2, I_SUBG, I_SBG, I_RELB, I_WO, I_GFFN, I_WRG, I_BRG, I_WRE, I_BRE, I_W1, I_W3, I_W2 };

__device__ __forceinline__ float wave_sum(float v) {
#pragma unroll
    for (int o = 1; o < 64; o <<= 1) v += __shfl_xor(v, o);
    return v;
}
template <int RMODE> __device__ __forceinline__ int rmap(int n) {
    if (RMODE == 1) { const int tl = n & 255; return (n & ~255) + 128 * ((tl & 63) >> 5) + 32 * (tl >> 6) + (tl & 31); }
    if (RMODE == 2) return (n >> 7) * 256 + (n & 127);
    if (RMODE == 3) return (n >> 7) * 256 + 128 + (n & 127);
    return n;
}
template <int RMODE> __device__ __forceinline__ void p0_transpose_item_f8(const float* W, int K, int N, unsigned char* WT, LAS float* scr, int item, int lane, const float* kscale, float mul) {
    const int nblk = N / 32, kb = item / nblk, nb = item % nblk, k0 = 64 * kb, n0 = 32 * nb;
    { f32x4 v[8]; const int n4 = (lane & 7) * 4;
#pragma unroll
      for (int i = 0; i < 8; ++i) v[i] = __builtin_nontemporal_load((const GAS f32x4*)(W + (size_t)(k0 + 8 * i + (lane >> 3)) * N + n0 + n4));
#pragma unroll
      for (int i = 0; i < 8; ++i) { LAS float* d = scr + (8 * i + (lane >> 3)) * 33 + n4; d[0] = v[i].x; d[1] = v[i].y; d[2] = v[i].z; d[3] = v[i].w; } }
    LDS_WAIT(); asm volatile("" ::: "memory");
    const int c = lane & 7;
#pragma unroll
    for (int j = 0; j < 4; ++j) { const int n = (lane >> 3) + 8 * j; const LAS float* s = scr + (8 * c) * 33 + n;
        float g8[8];
#pragma unroll
        for (int q = 0; q < 8; ++q) g8[q] = (kscale ? kscale[k0 + 8 * c + q] : 1.f) * mul;
        v2u o; o.x = pk4_fp8(s[0 * 33] * g8[0], s[1 * 33] * g8[1], s[2 * 33] * g8[2], s[3 * 33] * g8[3]); o.y = pk4_fp8(s[4 * 33] * g8[4], s[5 * 33] * g8[5], s[6 * 33] * g8[6], s[7 * 33] * g8[7]);
        *(GAS v2u*)(WT + (size_t)rmap<RMODE>(n0 + n) * K + k0 + 8 * c) = o; }
    LDS_WAIT(); asm volatile("" ::: "memory");
}
template <int RMODE> __device__ __forceinline__ void p0_transpose_item(const float* W, int K, int N, bf16* WT, LAS float* scr, int item, int lane, const float* kscale = nullptr) {
    const int nblk = N / 32, kb = item / nblk, nb = item % nblk, k0 = 64 * kb, n0 = 32 * nb;
    { f32x4 v[8]; const int n4 = (lane & 7) * 4;
#pragma unroll
      for (int i = 0; i < 8; ++i) v[i] = __builtin_nontemporal_load((const GAS f32x4*)(W + (size_t)(k0 + 8 * i + (lane >> 3)) * N + n0 + n4));
#pragma unroll
      for (int i = 0; i < 8; ++i) { LAS float* d = scr + (8 * i + (lane >> 3)) * 33 + n4; d[0] = v[i].x; d[1] = v[i].y; d[2] = v[i].z; d[3] = v[i].w; } }
    LDS_WAIT(); asm volatile("" ::: "memory");
    const int c = lane & 7;
#pragma unroll
    for (int j = 0; j < 4; ++j) { const int n = (lane >> 3) + 8 * j; const LAS float* s = scr + (8 * c) * 33 + n;
        float g8[8];
#pragma unroll
        for (int q = 0; q < 8; ++q) g8[q] = kscale ? kscale[k0 + 8 * c + q] : 1.f;
        v4u o; o.x = pk2(s[0 * 33] * g8[0], s[1 * 33] * g8[1]); o.y = pk2(s[2 * 33] * g8[2], s[3 * 33] * g8[3]); o.z = pk2(s[4 * 33] * g8[4], s[5 * 33] * g8[5]); o.w = pk2(s[6 * 33] * g8[6], s[7 * 33] * g8[7]);
        *(GAS v4u*)(WT + (size_t)rmap<RMODE>(n0 + n) * K + k0 + 8 * c) = o; }
    LDS_WAIT(); asm volatile("" ::: "memory");
}
__device__ __forceinline__ void p0_prologue(Frame& F) {
    LAS float* scr = (LAS float*)(F.lds + RING_OFF + F.wave * 16384);
    const int gw = F.vcu * NWAVES + F.wave, NGW = F.G * NWAVES;
    {
        const GAS f32x4* gp = (const GAS f32x4*)F.A->in[I_GATTN] + F.lane; f32x4 gg[4];
#pragma unroll
        for (int j = 0; j < 4; ++j) gg[j] = gp[64 * j];
        for (int m = gw; m < NTOK; m += NGW) {
            const GAS f32x4* xr = (const GAS f32x4*)(F.A->in[I_X] + (size_t)m * D) + F.lane;
            f32x4 v[4]; float s = 0.f;
#pragma unroll
            for (int j = 0; j < 4; ++j) { v[j] = __builtin_nontemporal_load(xr + 64 * j); s += (v[j].x * v[j].x + v[j].y * v[j].y) + (v[j].z * v[j].z + v[j].w * v[j].w); }
            const float rn = 1.0f / sqrtf(wave_sum(s) * (1.f / D) + EPS);
            GAS v2u* o8 = (GAS v2u*)((bf16*)(F.A->ws + WS_XN) + (size_t)m * D) + F.lane;
#pragma unroll
            for (int j = 0; j < 4; ++j) { v2u w; w.x = pk2(v[j].x * rn * gg[j].x, v[j].y * rn * gg[j].y); w.y = pk2(v[j].z * rn * gg[j].z, v[j].w * rn * gg[j].w); o8[64 * j] = w; }
        }
    }
    constexpr int I_IN = (D / 64) * (INW / 32), I_O = (D / 64) * (D / 32);
    for (int it = gw; it < I_IN + I_O; it += NGW) {
        int r = it;
        if (r < I_IN) { p0_transpose_item<1>(F.A->in[I_WIN], D, INW, (bf16*)(F.A->ws + WS_WIN), scr, r, F.lane); continue; } r -= I_IN;
        p0_transpose_item<0>(F.A->in[I_WO], D, D, (bf16*)(F.A->ws + WS_WO), scr, r, F.lane);
    }
    for (int it = gw; it < 32 * 3; it += NGW) {
        const int ks = it / 3, nb = it % 3, col = (F.lane & 15) + 16 * nb, kb = 32 * ks + 8 * (F.lane >> 4);
        unsigned hw[4], lw[4];
#pragma unroll
        for (int j = 0; j < 8; j += 2) { float v[2];
#pragma unroll
            for (int q = 0; q < 2; ++q) { const int k = kb + j + q; const float w = col < 4 ? F.A->in[I_WRG][k * 4 + col] : (col < 36 ? F.A->in[I_WRE][k * 32 + col - 4] : 0.f); v[q] = w * F.A->in[I_GFFN][k]; }
            const unsigned h0 = f2bf(v[0]), h1 = f2bf(v[1]); hw[j >> 1] = h0 | (h1 << 16); lw[j >> 1] = pk2(v[0] - bf2f(h0), v[1] - bf2f(h1)); }
        GAS v4u* dst = (GAS v4u*)(F.A->ws + WS_RF) + (size_t)(it * 2) * 64 + F.lane;
        dst[0] = (v4u){hw[0], hw[1], hw[2], hw[3]}; dst[64] = (v4u){lw[0], lw[1], lw[2], lw[3]};
    }
}

using pg8::Unit;
__device__ __forceinline__ float sum_fq(float v) {
    auto a = __builtin_amdgcn_permlane16_swap(__float_as_uint(v), __float_as_uint(v), false, false); v = __uint_as_float(a[0]) + __uint_as_float(a[1]);
    auto b = __builtin_amdgcn_permlane32_swap(__float_as_uint(v), __float_as_uint(v), false, false); return __uint_as_float(b[0]) + __uint_as_float(b[1]); }
struct EpiProj {
    bf16* P; const LAS float* gt;
    static __device__ __forceinline__ void build(LAS float* gt, const float* qg, const float* kg, int tid) {
        if (tid < 256) { const int m = tid >> 6, d = tid & 63; gt[tid] = m == 1 ? qg[d] * att::QSCALE : (m == 2 ? kg[d] : (m == 3 ? att::QSCALE : 1.f)); }
        __syncthreads(); }
    __device__ __forceinline__ void operator()(const pg8::f32x4 (&acc)[2][2][4][2], const Unit& u, int wr, int wc, int fr, int fq) const {
        const int mode = u.pn < 2 ? 1 : (u.pn < 4 ? 2 : ((u.pn == 6 || u.pn == 7) ? 3 : 0));
        float gv[2][2][4];
#pragma unroll
        for (int bj = 0; bj < 2; ++bj)
#pragma unroll
            for (int n = 0; n < 2; ++n) { const f32x4 g4 = *(const LAS f32x4*)(gt + mode * 64 + 32 * bj + 8 * fq + 4 * n);
#pragma unroll
                for (int i = 0; i < 4; ++i) gv[bj][n][i] = g4[i]; }
        const int row0 = u.pm * 256 + wr * 64 + fr;
#pragma unroll
        for (int ai = 0; ai < 2; ++ai)
#pragma unroll
            for (int m = 0; m < 4; ++m) {
                float rn = 1.f;
                if (mode == 1 || mode == 2) { float ss = 0.f;
#pragma unroll
                    for (int bj = 0; bj < 2; ++bj)
#pragma unroll
                        for (int n = 0; n < 2; ++n) { const pg8::f32x4 x = acc[ai][bj][m][n]; ss += (x[0] * x[0] + x[1] * x[1]) + (x[2] * x[2] + x[3] * x[3]); }
                    ss = sum_fq(ss);
                    rn = __builtin_amdgcn_rsqf(ss * (1.f / 64.f) + EPS); }
                bf16* rowp = (bf16*)((char*)P + (size_t)((4 * u.pn + wc) * 4 + (u.pm >> 5)) * att::BSTR) + ((row0 & 8191) + ai * 128 + m * 16) * 64 + 8 * fq;
#pragma unroll
                for (int bj = 0; bj < 2; ++bj) { const pg8::f32x4 v0 = acc[ai][bj][m][0], v1 = acc[ai][bj][m][1]; pg8::u32x4 w;
                    w.x = pg8::cvt_pk_bf16(v0[0] * rn * gv[bj][0][0], v0[1] * rn * gv[bj][0][1]); w.y = pg8::cvt_pk_bf16(v0[2] * rn * gv[bj][0][2], v0[3] * rn * gv[bj][0][3]);
                    w.z = pg8::cvt_pk_bf16(v1[0] * rn * gv[bj][1][0], v1[1] * rn * gv[bj][1][1]); w.w = pg8::cvt_pk_bf16(v1[2] * rn * gv[bj][1][2], v1[3] * rn * gv[bj][1][3]);
                    *(pg8::u32x4*)(rowp + bj * 32) = w; } }
    }
};
struct EpiOut {
    const float* x; bf16* X1; unsigned char* X8;
    __device__ __forceinline__ void operator()(const pg8::f32x4 (&acc)[2][2][4][2], const Unit& u, int wr, int wc, int fr, int fq) const {
        const int row0 = u.pm * 256 + wr * 64 + fr, col0 = u.pn * 256 + wc * 32 + 8 * fq;
#pragma unroll
        for (int ai = 0; ai < 2; ++ai)
#pragma unroll
            for (int m = 0; m < 4; ++m) { const size_t off = (size_t)(row0 + ai * 128 + m * 16) * D + col0;
#pragma unroll
                for (int bj = 0; bj < 2; ++bj) {
                    const pg8::f32x4 a0 = __builtin_nontemporal_load((const pg8::f32x4*)(x + off + bj * 128)), a1 = __builtin_nontemporal_load((const pg8::f32x4*)(x + off + bj * 128 + 4));
                    const pg8::f32x4 s0 = a0 + acc[ai][bj][m][0], s1 = a1 + acc[ai][bj][m][1]; pg8::u32x4 w;
                    w.x = pg8::cvt_pk_bf16(s0[0], s0[1]); w.y = pg8::cvt_pk_bf16(s0[2], s0[3]); w.z = pg8::cvt_pk_bf16(s1[0], s1[1]); w.w = pg8::cvt_pk_bf16(s1[2], s1[3]);
                    *(pg8::u32x4*)(X1 + off + bj * 128) = w;
                    v2u w8; w8.x = pk4_fp8(clamp448(s0[0]), clamp448(s0[1]), clamp448(s0[2]), clamp448(s0[3])); w8.y = pk4_fp8(clamp448(s1[0]), clamp448(s1[1]), clamp448(s1[2]), clamp448(s1[3]));
                    *(v2u*)(X8 + off + bj * 128) = w8; } }
    }
};
__device__ __forceinline__ float silu_mul(float a, float b) { return a * __builtin_amdgcn_rcpf(1.0f + __builtin_amdgcn_exp2f(-1.4426950408889634f * a)) * b; }
constexpr float HID_SCALE = 4.f;
struct EpiGate {
    unsigned char* H; const float* rns; const float* gates;
    __device__ __forceinline__ void operator()(const pg8::f32x4 (&acc)[2][2][4][2], const Unit& u, int wr, int wc, int fr, int fq) const {
        const int col0 = u.pn * 128 + wc * 32 + 8 * fq;
#pragma unroll
        for (int ai = 0; ai < 2; ++ai)
#pragma unroll
            for (int m = 0; m < 4; ++m) { const int r = ai * 128 + wr * 64 + m * 16 + fr; const float rn = (r < u.a1 ? rns[u.a0 + r] : 0.f) * (1.0f / W13_SCALE), gt = (r < u.a1 ? gates[u.a0 + r] : 0.f) * HID_SCALE;
                const pg8::f32x4 a0 = acc[ai][0][m][0] * rn, a1 = acc[ai][0][m][1] * rn, b0 = acc[ai][1][m][0] * (rn * gt), b1 = acc[ai][1][m][1] * (rn * gt); v2u w;
                w.x = pk4_fp8(clamp448(silu_mul(a0[0], b0[0])), clamp448(silu_mul(a0[1], b0[1])), clamp448(silu_mul(a0[2], b0[2])), clamp448(silu_mul(a0[3], b0[3])));
                w.y = pk4_fp8(clamp448(silu_mul(a1[0], b1[0])), clamp448(silu_mul(a1[1], b1[1])), clamp448(silu_mul(a1[2], b1[2])), clamp448(silu_mul(a1[3], b1[3])));
                *(v2u*)(H + (size_t)(u.pm * 256 + r) * EH + col0) = w; }
    }
};
constexpr float YS_SCALE = 16.f;
struct EpiDown {
    unsigned char* Y; const float* gates;
    __device__ __forceinline__ void operator()(const pg8::f32x4 (&acc)[2][2][4][2], const Unit& u, int wr, int wc, int fr, int fq) const {
        const int col0 = u.pn * 256 + wc * 32 + 8 * fq;
#pragma unroll
        for (int ai = 0; ai < 2; ++ai)
#pragma unroll
            for (int m = 0; m < 4; ++m) { const int r = ai * 128 + wr * 64 + m * 16 + fr; const float gt = YS_SCALE / (W2_SCALE * HID_SCALE);
#pragma unroll
                for (int bj = 0; bj < 2; ++bj) { const pg8::f32x4 v0 = acc[ai][bj][m][0] * gt, v1 = acc[ai][bj][m][1] * gt; v2u w;
                    w.x = pk4_fp8(clamp448(v0[0]), clamp448(v0[1]), clamp448(v0[2]), clamp448(v0[3])); w.y = pk4_fp8(clamp448(v1[0]), clamp448(v1[1]), clamp448(v1[2]), clamp448(v1[3]));
                    *(v2u*)(Y + (size_t)(u.pm * 256 + r) * D + col0 + bj * 128) = w; } }
    }
};
struct MoeOrder {
    pg8::StaticOrder so; const LAS int* be; const LAS int* bj; const LAS int* bn; const int* toks; unsigned rowbytes;
    __device__ __forceinline__ bool next(int i, Unit& u) const {
        if (!so.next(i, u)) return false;
        const int e = be[u.pm], j = bj[u.pm]; u.pb = e * 4 + u.pn; u.a0 = e * ECAP + 256 * j; u.a1 = bn[u.pm]; return true; }
    __device__ __forceinline__ unsigned arow_tok(const Unit& u, int r) const { return r < u.a1 ? (unsigned)toks[u.a0 + r] : 0u; }
};
template <bool REV, bool WAIT>
struct MoeOrderX {
    int start, nunits, r, n; const LAS int* be; const LAS int* bj; const LAS int* bn; const int* toks; gu32* done; int q, e;
    __device__ __forceinline__ bool next(int i, Unit& u) const {
        int k;
        if (!REV) k = i * n + r;
        else if (q >= 1 && 2 * e <= n) {
            if (i < q - 1) k = i * n + r; else { if (r < e) return false; k = (q - 1) * n + (i - (q - 1)) * (n - e) + (r - e); } }
        else k = i * n + (n - 1 - r);
        if (k >= nunits) return false;
        const int nbx = nunits >> 2, w = k & 31, fm = (k >> 5) << 3, rem = nbx - fm;
        int jb, pn; if (rem >= 8) { jb = fm + (w & 7); pn = w >> 3; } else { pn = w / rem; jb = fm + (w - pn * rem); }
        const int p = start + jb, e = be[p], j = bj[p];
        u.pm = p; u.pn = pn; u.pb = e * 4 + pn; u.a0 = e * ECAP + 256 * j; u.a1 = bn[p];
        if (WAIT) { gu32* d = done + 64 * p; unsigned sp = 0u;
            while (__hip_atomic_load(d, RLX_AGENT) < 32u) { __builtin_amdgcn_s_sleep(2); if (++sp > (1u << 22)) break; }
            asm volatile("" ::: "memory"); }
        return true; }
    __device__ __forceinline__ unsigned arow_tok(const Unit& u, int r_) const { return r_ < u.a1 ? (unsigned)toks[u.a0 + r_] : 0u; }
    __device__ __forceinline__ void done_unit(const Unit& u) const {
        if (!WAIT) { asm volatile("s_waitcnt vmcnt(0)" ::: "memory"); if ((threadIdx.x & 63) == 0) (void)__hip_atomic_fetch_add(done + 64 * u.pm, 1u, RLX_AGENT); } }
};
__device__ __forceinline__ int moe_tables(Frame& F) {
    LAS int* be = (LAS int*)(F.lds + MOE_OFF); LAS int* bj = be + MAXBLK; LAS int* bn = bj + MAXBLK; LAS int* nbp = bn + MAXBLK;
    LAS int* cl = (LAS int*)(F.lds + RING_OFF);
    if (F.tid < NEXP) cl[F.tid] = (int)__hip_atomic_load(F.ctl + CW_CNT + 64 * F.tid, RLX_AGENT);
    __syncthreads();
    if (F.tid < 64) {
        const int c = F.lane < NEXP ? cl[F.lane] : 0, nb = (c + 255) >> 8; int incl = nb;
#pragma unroll
        for (int o = 1; o < 64; o <<= 1) { const int v = __shfl_up(incl, o); if (F.lane >= o) incl += v; }
        const int p0 = incl - nb;
        for (int j = 0; j < nb; ++j) { const int p = p0 + j; if (p < MAXBLK) { be[p] = F.lane; bj[p] = j; bn[p] = (c - 256 * j) < 256 ? (c - 256 * j) : 256; } }
        const int tot = __shfl(incl, 63);
        if (F.lane == 0) *nbp = tot < MAXBLK ? tot : MAXBLK;
    }
    __syncthreads();
    return *nbp;
}

__device__ __forceinline__ void p4_router(Frame& F, int cw_cnt = CW_CNT, size_t dummy_off = 0) {
    typedef float f4 __attribute__((ext_vector_type(4)));
    LAS float* lg = (LAS float*)(F.lds + RING_OFF) + F.wave * (16 * 48);
    LAS float* ssl = (LAS float*)(F.lds + RING_OFF + 24576) + F.wave * 16;
    LAS unsigned* hist = (LAS unsigned*)(F.lds + RING_OFF + 25600);
    LAS unsigned* base = hist + 32;
    const bf16* x1 = (const bf16*)(F.A->ws + WS_U);
    const GAS v4u* rfg = (const GAS v4u*)(F.A->ws + WS_RF);
    LAS v4u* rfl = (LAS v4u*)(F.lds + RING_OFF + 32768);
    for (int g0 = (int)blockIdx.x * 128; g0 < NTOK; g0 += (int)gridDim.x * 128) {
        if (F.tid < 32) hist[F.tid] = 0u;
        const int t0 = g0 + F.wave * 16;
        f4 acc[3]; acc[0] = (f4){0.f, 0.f, 0.f, 0.f}; acc[1] = acc[0]; acc[2] = acc[0]; float ssq = 0.f;
        const GAS v4u* xr = (const GAS v4u*)(x1 + (size_t)(t0 + (F.lane & 15)) * D + 8 * (F.lane >> 4));
#pragma unroll 1
        for (int half = 0; half < 2; ++half) {
            __syncthreads();
#pragma unroll
            for (int i = 0; i < 12; ++i) rfl[i * 512 + F.tid] = rfg[(size_t)half * 6144 + i * 512 + F.tid];
            __syncthreads();
#pragma unroll 4
            for (int k2 = 0; k2 < 16; ++k2) {
                const int ks = half * 16 + k2;
                const v4u a = xr[4 * ks];
                { const float v0 = bf2f(a.x & 0xffffu), v1 = bf2f(a.x >> 16), v2 = bf2f(a.y & 0xffffu), v3 = bf2f(a.y >> 16), v4 = bf2f(a.z & 0xffffu), v5 = bf2f(a.z >> 16), v6 = bf2f(a.w & 0xffffu), v7 = bf2f(a.w >> 16);
                  ssq += (v0 * v0 + v1 * v1) + (v2 * v2 + v3 * v3) + (v4 * v4 + v5 * v5) + (v6 * v6 + v7 * v7); }
                const bf16x8 Ah = __builtin_bit_cast(bf16x8, a);
#pragma unroll
                for (int nb = 0; nb < 3; ++nb) { const bf16x8 Bh = __builtin_bit_cast(bf16x8, rfl[((k2 * 3 + nb) * 2) * 64 + F.lane]), Bl = __builtin_bit_cast(bf16x8, rfl[((k2 * 3 + nb) * 2 + 1) * 64 + F.lane]);
                    acc[nb] = __builtin_amdgcn_mfma_f32_16x16x32_bf16(Ah, Bh, acc[nb], 0, 0, 0);
                    acc[nb] = __builtin_amdgcn_mfma_f32_16x16x32_bf16(Ah, Bl, acc[nb], 0, 0, 0); }
            }
        }
        ssq += __shfl_xor(ssq, 16); ssq += __shfl_xor(ssq, 32);
        if (F.lane < 16) ssl[F.lane] = ssq;
#pragma unroll
        for (int nb = 0; nb < 3; ++nb)
#pragma unroll
            for (int r = 0; r < 4; ++r) lg[((F.lane >> 4) * 4 + r) * 48 + (F.lane & 15) + 16 * nb] = acc[nb][r];
        LDS_WAIT(); asm volatile("" ::: "memory");
        int e1 = 0, e2 = 0; unsigned r1 = 0, r2 = 0; float g1 = 0.f, g2 = 0.f, rn = 0.f;
        if (F.lane < 16) {
            rn = 1.0f / sqrtf(ssl[F.lane] * (1.f / D) + EPS);
            const LAS float* L = lg + F.lane * 48;
            float gl[4]; int gsel = 0; float gm;
#pragma unroll
            for (int j = 0; j < 4; ++j) gl[j] = L[j] * rn + F.A->in[I_BRG][j];
            gm = gl[0];
#pragma unroll
            for (int j = 1; j < 4; ++j) if (gl[j] > gm) { gm = gl[j]; gsel = j; }
            float gs = 0.f;
#pragma unroll
            for (int j = 0; j < 4; ++j) gs += expf(gl[j] - gm);
            const float pg = 1.0f / gs;
            float el[8];
#pragma unroll
            for (int j = 0; j < 8; ++j) el[j] = L[4 + 8 * gsel + j] * rn + F.A->in[I_BRE][8 * gsel + j];
            int i1 = 0; float m1 = el[0];
#pragma unroll
            for (int j = 1; j < 8; ++j) if (el[j] > m1) { m1 = el[j]; i1 = j; }
            int i2 = -1; float m2 = -INFINITY;
#pragma unroll
            for (int j = 0; j < 8; ++j) if (j != i1 && el[j] > m2) { m2 = el[j]; i2 = j; }
            const float p2 = expf(m2 - m1);
            g1 = pg / (1.0f + p2); g2 = pg * p2 / (1.0f + p2);
            e1 = gsel * 8 + i1; e2 = gsel * 8 + i2;
            r1 = atomicAdd((unsigned*)(hist + e1), 1u); r2 = atomicAdd((unsigned*)(hist + e2), 1u);
        }
        __syncthreads();
        if (F.tid < 32) { const unsigned c = hist[F.tid]; base[F.tid] = c ? __hip_atomic_fetch_add(F.ctl + cw_cnt + 64 * F.tid, c, RLX_AGENT) : 0u; }
        __syncthreads();
        if (F.lane < 16) {
            const int t = t0 + F.lane; const int s1 = (int)(base[e1] + r1), s2 = (int)(base[e2] + r2);
            int* toks = (int*)(F.A->ws + WS_TOKS + dummy_off); float* gates = (float*)(F.A->ws + WS_GATES + dummy_off); float* rns = (float*)(F.A->ws + WS_RNS + dummy_off);
            toks[e1 * ECAP + s1] = t; gates[e1 * ECAP + s1] = g1; rns[e1 * ECAP + s1] = rn;
            toks[e2 * ECAP + s2] = t; gates[e2 * ECAP + s2] = g2; rns[e2 * ECAP + s2] = rn;
            ((int4*)(F.A->ws + WS_REC + dummy_off))[t] = make_int4(e1, s1, e2, s2);
        }
        __syncthreads();
    }
}
__device__ __forceinline__ void p7_combine(Frame& F) {
    const int gw = F.vcu * NWAVES + F.wave, NGW = F.G * NWAVES;
    int ps = 0;
    { const int c = F.lane < 32 ? (int)__hip_atomic_load(F.ctl + CW_CNT + 64 * (F.lane & 31), RLX_AGENT) : 0; const int p = ((c + 255) >> 8) << 8; int incl = p;
#pragma unroll
      for (int o = 1; o < 32; o <<= 1) { const int v = __shfl_up(incl, o); if ((F.lane & 31) >= o) incl += v; }
      ps = incl - p; }
    const unsigned char* Y = (const unsigned char*)(F.A->ws + WS_YS);
    int4 rcn = gw < NTOK ? ((const int4*)(F.A->ws + WS_REC))[gw] : make_int4(0, 0, 0, 0);
    for (int t = gw; t < NTOK; t += NGW) {
        const int4 rc = rcn; if (t + NGW < NTOK) rcn = ((const int4*)(F.A->ws + WS_REC))[t + NGW];
        const int ra = __shfl(ps, rc.x) + rc.y, rb = __shfl(ps, rc.z) + rc.w;
        const GAS v2u* xr = (const GAS v2u*)((const bf16*)(F.A->ws + WS_U) + (size_t)t * D) + F.lane; GAS f32x4* orow = (GAS f32x4*)(F.A->out + (size_t)t * D) + F.lane;
        const GAS unsigned* ya = (const GAS unsigned*)(Y + (size_t)ra * D) + F.lane; const GAS unsigned* yb = (const GAS unsigned*)(Y + (size_t)rb * D) + F.lane;
#pragma unroll
        for (int j = 0; j < 4; ++j) { const v2u xv = __builtin_nontemporal_load(xr + 64 * j); f32x4 v; v.x = bf2f(xv.x & 0xffffu); v.y = bf2f(xv.x >> 16); v.z = bf2f(xv.y & 0xffffu); v.w = bf2f(xv.y >> 16);
            const unsigned a = __builtin_nontemporal_load(ya + 64 * j), b = __builtin_nontemporal_load(yb + 64 * j); f32x4 o;
            typedef float f2 __attribute__((ext_vector_type(2)));
            const f2 a0 = __builtin_amdgcn_cvt_pk_f32_fp8((int)a, false), a1 = __builtin_amdgcn_cvt_pk_f32_fp8((int)a, true), b0 = __builtin_amdgcn_cvt_pk_f32_fp8((int)b, false), b1 = __builtin_amdgcn_cvt_pk_f32_fp8((int)b, true);
            o.x = v.x + (a0.x + b0.x) * (1.0f / YS_SCALE); o.y = v.y + (a0.y + b0.y) * (1.0f / YS_SCALE); o.z = v.z + (a1.x + b1.x) * (1.0f / YS_SCALE); o.w = v.w + (a1.y + b1.y) * (1.0f / YS_SCALE); __builtin_nontemporal_store(o, orow + 64 * j); }
    }
}

__device__ __forceinline__ int rel_bucket(int rel) {
    const int n = rel < 0 ? -rel : rel; int b;
    if (n < 8) b = n;
    else { b = 8 + (int)(logf((float)n * 0.125f) / 2.772588722239781f * 8.0f); if (n == 16) b = 10; if (n == 32) b = 12; if (n == 64) b = 14; if (b > 15) b = 15; }
    return (rel > 0 ? 16 : 0) + b;
}
__device__ __forceinline__ att::Tabs mixer_tables(Frame& F) {
    LAS float* btab = (LAS float*)(F.lds + TAB_OFF); LAS float* gsub = btab + 1024; LAS float* gsb = gsub + 128;
    for (int i = F.tid; i < 1024; i += NWAVES * 64) { const int h = i >> 8, rel = (i & 255) - 128; btab[i] = (F.A->in[I_RELB][rel_bucket(rel) * 4 + h] - F.A->in[I_RELB][rel_bucket(-128) * 4 + h]) * att::LOG2E; }
    if (F.tid < 128) gsub[F.tid] = F.A->in[I_SUBG][F.tid] * (1.0f - LAMBDA_INIT);
    if (F.tid < 64) gsb[F.tid] = F.A->in[I_SBG][F.tid];
    float s1 = F.A->in[I_LQ1][F.lane] * F.A->in[I_LK1][F.lane], s2 = F.A->in[I_LQ2][F.lane] * F.A->in[I_LK2][F.lane];
    s1 = wave_sum(s1); s2 = wave_sum(s2);
    att::Tabs T; T.btab = btab; T.gsub = gsub; T.gsb = gsb; T.lam = expf(s1) - expf(s2) + LAMBDA_INIT;
    { float mq = fabsf(F.A->in[I_QNG][F.lane]), mk = fabsf(F.A->in[I_KNG][F.lane]), mb = fmaxf(fabsf(F.A->in[I_RELB][F.lane]), fabsf(F.A->in[I_RELB][64 + F.lane]));
#pragma unroll
      for (int o = 1; o < 64; o <<= 1) { mq = fmaxf(mq, __shfl_xor(mq, o)); mk = fmaxf(mk, __shfl_xor(mk, o)); mb = fmaxf(mb, __shfl_xor(mb, o)); }
      const float bound = 64.f * mq * mk * att::QSCALE + 2.f * mb * att::LOG2E;
      T.online = !(bound <= 48.f); }
    __syncthreads();
    return T;
}
constexpr int NCONV = 64;
__device__ __forceinline__ void p2_convert_experts(Frame& F) {
    LAS float* scr = (LAS float*)(F.lds + RING_OFF + F.wave * 16384);
    constexpr int I_13 = (D / 64) * (EH / 32), I_2 = (EH / 64) * (D / 32), PER_E = 2 * I_13 + I_2;
    const int cw = (int)blockIdx.x * NWAVES + F.wave;
    for (int it = cw; it < NEXP * PER_E; it += NCONV * NWAVES) {
        const int e = it / PER_E; int r = it - e * PER_E;
        if (r < I_13) { p0_transpose_item_f8<2>(F.A->in[I_W1] + (size_t)e * D * EH, D, EH, (unsigned char*)(F.A->ws + WS_W13) + (size_t)e * 1024 * D, scr, r, F.lane, F.A->in[I_GFFN], W13_SCALE); continue; } r -= I_13;
        if (r < I_13) { p0_transpose_item_f8<3>(F.A->in[I_W3] + (size_t)e * D * EH, D, EH, (unsigned char*)(F.A->ws + WS_W13) + (size_t)e * 1024 * D, scr, r, F.lane, F.A->in[I_GFFN], W13_SCALE); continue; } r -= I_13;
        p0_transpose_item_f8<0>(F.A->in[I_W2] + (size_t)e * EH * D, EH, D, (unsigned char*)(F.A->ws + WS_W2) + (size_t)e * D * EH, scr, r, F.lane, nullptr, W2_SCALE);
    }
    __syncthreads();
}
__device__ __forceinline__ int mixer_dequeue(Frame& F, unsigned xcc, int qbase, int nunits, volatile LAS int* qw) {
    if (F.tid == 0) { int found = -1;
        for (int k = 0; k < 8; ++k) { const int q = (int)((xcc + k) & 7u); gu32* hw = F.ctl + CW_Q + 64 * (qbase + q);
            const unsigned i = __hip_atomic_fetch_add(hw, 1u, RLX_AGENT);
            if (i < (unsigned)nunits) { found = (q << 16) | (int)i; break; } }
        qw[0] = found; }
    __syncthreads();
    const int r = __builtin_amdgcn_readfirstlane(qw[0]);
    __syncthreads();
    return r;
}
__device__ __forceinline__ void p2_mixer(Frame& F, unsigned xcc, char* ring, int qbank = 0, bool do_da = true, bool do_sb = true) {
    const att::Tabs T = mixer_tables(F);
    const att::bf16* PROJ = (const att::bf16*)(F.A->ws + WS_PROJ); att::bf16* MIX = (att::bf16*)(F.A->ws + WS_XN);
    volatile LAS int* qw = (volatile LAS int*)(F.MISC + 16);
    if (!T.online) {
        for (;;) {
            if (!do_da) break; const int r = mixer_dequeue(F, xcc, qbank + 0, 128, qw); if (r < 0) break;
            const int xq = r >> 16, qi = r & 0xffff, bh = 2 * xq + (qi >> 6), qb = 63 - (qi & 63);
            att::da_unit<false>(bh >> 2, bh & 3, qb, PROJ, MIX, ring, T);
        }
    } else {
        for (;;) {
            if (!do_da) break; const int r = mixer_dequeue(F, xcc, qbank + 0, 128, qw); if (r < 0) break;
            const int xq = r >> 16, qi = r & 0xffff, bh = 2 * xq + (qi >> 6), qb = 63 - (qi & 63);
            att::da_unit<true>(bh >> 2, bh & 3, qb, PROJ, MIX, ring, T);
        }
    }
    for (;;) {
        if (!do_sb) break; const int r = mixer_dequeue(F, xcc, qbank + 8, 128, qw); if (r < 0) break;
        const int xq = r >> 16, j = r & 0xffff, pr = 2 * xq + (j >> 6), qb = 63 - (j & 63);
#ifndef NO_SB
        att::sb_unit(pr >> 2, pr & 3, qb, PROJ, MIX, ring, T);
#endif
    }
}
#ifndef REP_MASK
#define REP_MASK 0
#endif
__global__ void __launch_bounds__(NWAVES * 64, 2) mk_fwd(Args args) {
    extern __shared__ __attribute__((aligned(16))) unsigned char lds[];
    Frame F;
    F.lds = (LAS unsigned char*)lds;
    F.MISC = (volatile LAS unsigned*)(F.lds + MISC_OFF);
    F.tid = threadIdx.x; F.lane = F.tid & 63; F.wave = __builtin_amdgcn_readfirstlane(F.tid >> 6);
    F.G = gridDim.x; { const int bx = blockIdx.x; F.vcu = (F.G % 8 == 0) ? (bx % 8) * (F.G / 8) + bx / 8 : bx; }
    F.A = &args; F.ctl = (gu32*)(args.ws + WS_CTL);
    for (int u = F.tid; u < (LDS_BYTES - LDSCTL_OFF) / 4; u += NWAVES * 64) ((LAS unsigned*)(F.lds + LDSCTL_OFF))[u] = 0u;
    __syncthreads();
    XcdBarrier bar; bar.bar = (unsigned*)(F.ctl + CW_BAR); bar.x = xb_xcc_id(); bar.st = nullptr;
    if (MK_N_LAUNCHES == 1) bar = xcd_barrier_post((unsigned*)(F.ctl + CW_BAR), F.MISC + 8);
#define GRID_BAR() do { if (MK_N_LAUNCHES == 1) xcd_barrier(bar); } while (0)
    const int lo = args.ph_lo, hi = args.ph_hi;
#define IN(k) (lo <= (k) && (k) < hi)
#ifdef ONLY_PH
#define PH_ON(k) ((k) == ONLY_PH)
#else
#define PH_ON(k) true
#endif
#define REPS(k) (((REP_MASK >> (k)) & 1) ? 2 : 1)
    if (PH_ON(0) && IN(0)) { for (int rep = 0; rep < REPS(0); ++rep) p0_prologue(F); GRID_BAR(); }
    if (PH_ON(1) && IN(1)) {
        pg8::Gemm g{(const pg8::bf16_t*)(args.ws + WS_XN), (const pg8::bf16_t*)(args.ws + WS_WIN), D};
        pg8::StaticOrder S; S.init(NTOK / 256, INW / 256, F.G, (int)blockIdx.x);
        EpiProj::build((LAS float*)(F.lds + TAB_OFF), args.in[I_QNG], args.in[I_KNG], F.tid);
        EpiProj E{(bf16*)(args.ws + WS_PROJ), (const LAS float*)(F.lds + TAB_OFF)};
        pg8::gemm_phase<EpiProj, pg8::StaticOrder, false>(F.lds + RING_OFF, g, S, E);
        GRID_BAR();
    }
    if (PH_ON(2) && IN(2)) {
        if ((int)blockIdx.x < NCONV) p2_convert_experts(F);
        p2_mixer(F, bar.x, (char*)lds + RING_OFF);
        if (REP_MASK & 0x100) p2_mixer(F, bar.x, (char*)lds + RING_OFF, 16, true, false);
        if (REP_MASK & 0x200) p2_mixer(F, bar.x, (char*)lds + RING_OFF, 32, false, true);
        GRID_BAR(); }
    if (PH_ON(3) && IN(3)) {
        pg8::Gemm g{(const pg8::bf16_t*)(args.ws + WS_XN), (const pg8::bf16_t*)(args.ws + WS_WO), D};
        pg8::StaticOrder S; S.init(NTOK / 256, D / 256, F.G, (int)blockIdx.x);
        EpiOut E{args.in[I_X], (bf16*)(args.ws + WS_U), (unsigned char*)(args.ws + WS_X1F8)};
        for (int rep = 0; rep < REPS(3); ++rep) pg8::gemm_phase<EpiOut, pg8::StaticOrder, false>(F.lds + RING_OFF, g, S, E);
        GRID_BAR();
    }
    if (PH_ON(4) && IN(4)) { if (REP_MASK & 0x10) p4_router(F, CW_CNT + 2048, 64 * MiB); p4_router(F); GRID_BAR(); }
    if ((PH_ON(5) && IN(5)) || (PH_ON(6) && IN(6))) {
        const int NB = moe_tables(F);
        LAS int* be = (LAS int*)(F.lds + MOE_OFF);
        int start = 0, nbx = NB, rk = (int)blockIdx.x, nloc = F.G;
        if (MK_N_LAUNCHES == 1) { unsigned pre = 0u, mine = 0u, tot = 0u;
#pragma unroll
            for (unsigned j = 0; j < 16; ++j) { const unsigned c = (unsigned)__builtin_amdgcn_readfirstlane((int)xb_ld(bar.bar + XB_XCNT(j))); pre += j < bar.x ? c : 0u; mine = j == bar.x ? c : mine; tot += c; }
            start = (int)((unsigned)NB * pre / tot); nbx = (int)((unsigned)NB * (pre + mine) / tot) - start; rk = (int)F.MISC[12]; nloc = (int)mine; }
        rk = __builtin_amdgcn_readfirstlane(rk);
        gu32* done = F.ctl + CW_DONE; const int rq = (nbx * 4) / (nloc > 0 ? nloc : 1), re = nbx * 4 - rq * nloc;
        if (PH_ON(5) && IN(5)) {
            MoeOrderX<false, false> S{start, nbx * 4, rk, nloc, be, be + MAXBLK, be + 2 * MAXBLK, (const int*)(args.ws + WS_TOKS), done, rq, re};
            pg8::Gemm g{(const pg8::bf16_t*)(args.ws + WS_X1F8), (const pg8::bf16_t*)(args.ws + WS_W13), D};
            EpiGate E{(unsigned char*)(args.ws + WS_HID), (const float*)(args.ws + WS_RNS), (const float*)(args.ws + WS_GATES)};
            pg8::gemm_phase<EpiGate, MoeOrderX<false, false>, true, 1>(F.lds + RING_OFF, g, S, E);
        }
        if (PH_ON(6) && IN(6)) {
            MoeOrderX<true, true> S{start, nbx * 4, rk, nloc, be, be + MAXBLK, be + 2 * MAXBLK, (const int*)(args.ws + WS_TOKS), done, rq, re};
            pg8::Gemm g{(const pg8::bf16_t*)(args.ws + WS_HID), (const pg8::bf16_t*)(args.ws + WS_W2), EH};
            EpiDown E{(unsigned char*)(args.ws + WS_YS), (const float*)(args.ws + WS_GATES)};
            pg8::gemm_phase<EpiDown, MoeOrderX<true, true>, false, 1>(F.lds + RING_OFF, g, S, E);
            GRID_BAR();
        }
    }
    if (PH_ON(7) && IN(7)) { for (int rep = 0; rep < REPS(7); ++rep) p7_combine(F); }
#undef IN
#undef GRID_BAR
}

#if defined(DBG_NAIVE_ATTN)
#define PROJ_IDX(row, col) ((size_t)(((col) >> 6) * 4 + ((row) >> 13)) * (att::BSTR / 2) + (size_t)((row) & 8191) * 64 + ((col) & 63))
__global__ void __launch_bounds__(128) naive_da(const bf16* __restrict__ P, bf16* __restrict__ MIX, const float* relb, const float* subg, const float* lq1, const float* lk1, const float* lq2, const float* lk2) {
    __shared__ float sm[32 * 64 * 2 + 32 * 128];
    const int tid = threadIdx.x, qi = tid & 63, map = tid >> 6;
    const int bh = blockIdx.x >> 7, c = blockIdx.x & 127, b = bh >> 2, h = bh & 3;
    const size_t rowbase = (size_t)b * 8192; const int qpos = c * 64 + qi;
    float q[64], o[128];
    for (int d = 0; d < 64; ++d) q[d] = bf2f(P[PROJ_IDX(rowbase + qpos, h * 128 + map * 64 + d)]);
    for (int d = 0; d < 128; ++d) o[d] = 0.f;
    float m = -INFINITY, l = 0.f;
    float s1 = 0.f, s2 = 0.f; for (int d = 0; d < 64; ++d) { s1 += lq1[d] * lk1[d]; s2 += lq2[d] * lk2[d]; }
    const float lam = expf(s1) - expf(s2) + LAMBDA_INIT;
    const int nkeys = 64 * (c + 1);
    for (int k0 = 0; k0 < nkeys; k0 += 32) {
        __syncthreads();
        for (int i = tid; i < 32 * 128; i += 128) { const int j = i >> 7, d = i & 127; sm[(d >> 6) * 2048 + j * 64 + (d & 63)] = bf2f(P[PROJ_IDX(rowbase + k0 + j, 512 + h * 128 + d)]); sm[4096 + j * 128 + d] = bf2f(P[PROJ_IDX(rowbase + k0 + j, 1024 + h * 128 + d)]); }
        __syncthreads();
        for (int j = 0; j < 32; ++j) {
            float s = 0.f; const float* kr = sm + map * 2048 + j * 64;
            for (int d = 0; d < 64; ++d) s += q[d] * kr[d];
            s += relb[rel_bucket(k0 + j - qpos) * 4 + h] * att::LOG2E;
            const float mn = fmaxf(m, s), al = exp2f(m - mn), p = exp2f(s - mn);
            l = l * al + p; m = mn; const float* vr = sm + 4096 + j * 128;
            for (int d = 0; d < 128; ++d) o[d] = o[d] * al + p * vr[d];
        }
    }
    __syncthreads();
    const float li = 1.0f / l;
    if (map == 1) for (int d = 0; d < 128; ++d) sm[qi * 128 + d] = o[d] * li;
    __syncthreads();
    if (map == 0) { float ss = 0.f;
        for (int d = 0; d < 128; ++d) { o[d] = o[d] * li - lam * sm[qi * 128 + d]; ss += o[d] * o[d]; }
        const float rn = 1.0f / sqrtf(ss / 128.f + EPS);
        for (int d = 0; d < 128; ++d) MIX[(rowbase + qpos) * 1024 + h * 128 + d] = (bf16)f2bf(o[d] * rn * subg[d] * (1.0f - LAMBDA_INIT)); }
}
__global__ void __launch_bounds__(64) naive_sb(const bf16* __restrict__ P, bf16* __restrict__ MIX, const float* sbg) {
    __shared__ float sm[32 * 64 * 2];
    const int tid = threadIdx.x;
    const int bh = blockIdx.x >> 7, c = blockIdx.x & 127, b = bh >> 3, h = bh & 7;
    const size_t rowbase = (size_t)b * 8192; const int qpos = c * 64 + tid;
    float q[64], o[64];
    for (int d = 0; d < 64; ++d) { q[d] = bf2f(P[PROJ_IDX(rowbase + qpos, 1536 + h * 64 + d)]); o[d] = 0.f; }
    float between = 0.f;
    for (int k0 = 64 * c + 32; k0 >= 0; k0 -= 32) {
        __syncthreads();
        for (int i = tid; i < 32 * 64; i += 64) { const int j = i >> 6, d = i & 63; sm[j * 64 + d] = bf2f(P[PROJ_IDX(rowbase + k0 + j, 2048 + h * 64 + d)]); sm[2048 + j * 64 + d] = bf2f(P[PROJ_IDX(rowbase + k0 + j, 2560 + h * 64 + d)]); }
        __syncthreads();
        for (int j = 31; j >= 0; --j) {
            if (k0 + j >= qpos) continue;
            float s = 0.f; const float* kr = sm + j * 64;
            for (int d = 0; d < 64; ++d) s += q[d] * kr[d];
            const float z = s * 0.6931471805599453f;
            const float sp = fmaxf(z, 0.f) + log1pf(expf(-fabsf(z)));
            const float a = expf((z - sp) + between);
            between += -sp;
            const float* vr = sm + 2048 + j * 64;
            for (int d = 0; d < 64; ++d) o[d] += a * vr[d];
        }
    }
    float ss = 0.f; for (int d = 0; d < 64; ++d) ss += o[d] * o[d];
    const float rn = 1.0f / sqrtf(ss / 64.f + EPS);
    for (int d = 0; d < 64; ++d) MIX[(rowbase + qpos) * 1024 + 512 + h * 64 + d] = (bf16)f2bf(o[d] * rn * sbg[d]);
}
#endif

extern "C" void kernel_launch(void* const* d_in, const int* in_sizes, int n_in, void* d_out, int out_size, void* d_ws, size_t ws_size, hipStream_t stream) {
    static int grid = 0;
    if (grid == 0) {
        if (n_in != 21 || in_sizes[0] != NTOK * D || out_size != NTOK * D || ws_size < WS_END) { fprintf(stderr, "kernel_launch: unexpected shapes / workspace (n_in %d, ws %zu); nothing launched\n", n_in, ws_size); grid = -1; return; }
        int dev = 0, cus = 0, per_cu = 0;
        if (hipGetDevice(&dev) != hipSuccess || hipDeviceGetAttribute(&cus, hipDeviceAttributeMultiprocessorCount, dev) != hipSuccess) { grid = -1; return; }
        if (hipFuncSetAttribute((const void*)mk_fwd, hipFuncAttributeMaxDynamicSharedMemorySize, LDS_BYTES) != hipSuccess) { fprintf(stderr, "kernel_launch: hipFuncSetAttribute failed\n"); grid = -1; return; }
        if (hipOccupancyMaxActiveBlocksPerMultiprocessor(&per_cu, (const void*)mk_fwd, NWAVES * 64, LDS_BYTES) != hipSuccess || per_cu < 1) { fprintf(stderr, "kernel_launch: occupancy query reports %d workgroups per CU\n", per_cu); grid = -1; (void)hipGetLastError(); return; }
        (void)hipGetLastError();
        grid = cus;
    }
    if (grid < 0) return;
    if (hipMemsetAsync((char*)d_ws + WS_CTL, 0, CTL_ZERO_BYTES, stream) != hipSuccess) return;
    Args a{};
    for (int i = 0; i < 21; ++i) a.in[i] = (const float*)d_in[i];
    a.out = (float*)d_out; a.ws = (unsigned char*)d_ws; a.rep1 = (REP_MASK & 0x2) ? 2 : 1; a.pad = 0;
#if MK_N_LAUNCHES == 1
#if defined(PROBE_P1_RELAUNCH)
    a.ph_lo = 0; a.ph_hi = 2;
    hipLaunchKernelGGL(mk_fwd, dim3(grid), dim3(NWAVES * 64), LDS_BYTES, stream, a);
    (void)hipMemsetAsync((char*)d_ws + WS_CTL, 0, CTL_ZERO_BYTES, stream);
    a.ph_lo = 1; a.ph_hi = 8;
    hipLaunchKernelGGL(mk_fwd, dim3(grid), dim3(NWAVES * 64), LDS_BYTES, stream, a);
#else
    a.ph_lo = 0; a.ph_hi = 8;
    hipLaunchKernelGGL(mk_fwd, dim3(grid), dim3(NWAVES * 64), LDS_BYTES, stream, a);
#endif
#else
    for (int ph = 0; ph < 8; ++ph) {
#if defined(DBG_NAIVE_ATTN)
        if (ph == 2) {
            a.ph_lo = 2; a.ph_hi = 3; hipLaunchKernelGGL(mk_fwd, dim3(grid), dim3(NWAVES * 64), LDS_BYTES, stream, a);
            hipLaunchKernelGGL(naive_da, dim3(16 * 128), dim3(128), 0, stream, (const bf16*)((char*)d_ws + WS_PROJ), (bf16*)((char*)d_ws + WS_XN), (const float*)d_in[I_RELB], (const float*)d_in[I_SUBG],
                               (const float*)d_in[I_LQ1], (const float*)d_in[I_LK1], (const float*)d_in[I_LQ2], (const float*)d_in[I_LK2]);
            hipLaunchKernelGGL(naive_sb, dim3(32 * 128), dim3(64), 0, stream, (const bf16*)((char*)d_ws + WS_PROJ), (bf16*)((char*)d_ws + WS_XN), (const float*)d_in[I_SBG]);
            continue;
        }
#endif
        a.ph_lo = ph; a.ph_hi = ph + 1;
        hipLaunchKernelGGL(mk_fwd, dim3(grid), dim3(NWAVES * 64), LDS_BYTES, stream, a);
    }
#endif
}
```

```cpp
#include <hip/hip_runtime.h>
#include <hip/hip_bf16.h>
#include <cstdio>
#include <cstdint>
#include <cmath>
namespace pg8 {
#define PG8_LAS __attribute__((address_space(3)))
typedef unsigned short bf16_t;
typedef short bf16x8 __attribute__((ext_vector_type(8)));
typedef float f32x4 __attribute__((ext_vector_type(4)));
typedef float f32x2 __attribute__((ext_vector_type(2)));
typedef unsigned u32x4 __attribute__((ext_vector_type(4)));
constexpr int BM = 256, BK = 64, HALF = 128, HTB = HALF * BK * 2  , STAGE_BYTES = 8 * HTB, NXCD = 8, WGM = 8;

__host__ __device__ __forceinline__ int lds_byte(int r, int c) { const int st = (r >> 4) * 2 + (c >> 5), rr = r & 15, cc = c & 31, ob = rr * 64 + cc * 2; return st * 1024 + (ob ^ (((ob >> 9) & 1) << 5)); }
__host__ __device__ __forceinline__ void stage_rc(int b, int& R, int& C) { const int st = b / 1024, sb = b % 1024, swz = sb ^ (((sb >> 9) & 1) << 5); R = (st >> 1) * 16 + swz / 64; C = (st & 1) * 32 + (swz % 64) / 2; }
__host__ __device__ __forceinline__ int perm32(int rho) { const int n = rho >> 4, i = rho & 15; return 8 * (i >> 2) + 4 * n + (i & 3); }

struct Unit { int pm, pn, pb, a0, a1; };
struct Gemm { const bf16_t* A; const bf16_t* Bt; int K; };

struct StaticOrder {
    int nM, nN, nwg, G, c;
    __host__ __device__ void init(int nM_, int nN_, int G_, int c_) { nM = nM_; nN = nN_; nwg = nM * nN; G = G_; c = c_; }
    __host__ __device__ bool next(int i, Unit& u) const {
        const long L = (long)i * G + c; if (L >= nwg) return false;
        int wgid = (int)L; { const int q = nwg / NXCD, r = nwg % NXCD, xcd = wgid % NXCD, off = wgid / NXCD; wgid = (xcd < r ? xcd * (q + 1) : r * (q + 1) + (xcd - r) * q) + off; }
        const int nig = WGM * nN, gid = wgid / nig, fm = gid * WGM, gsz = (nM - fm) < WGM ? (nM - fm) : WGM;
        u.pm = fm + ((wgid % nig) % gsz); u.pn = (wgid % nig) / gsz; u.pb = u.pn; u.a0 = 0; u.a1 = 0; return true;
    }
    __device__ __forceinline__ unsigned arow_tok(const Unit&, int) const { return 0u; }
    __device__ __forceinline__ void done_unit(const Unit&) const {}
};

__device__ __forceinline__ unsigned cvt_pk_bf16(float lo, float hi) { unsigned r; asm volatile("v_cvt_pk_bf16_f32 %0, %1, %2" : "=v"(r) : "v"(lo), "v"(hi)); return r; }

typedef int v8i32 __attribute__((ext_vector_type(8)));
typedef unsigned u32x8 __attribute__((ext_vector_type(8)));
template <class Epi, class Sched, bool GATHER, int EB = 2>
__device__ __forceinline__ void gemm_phase(PG8_LAS unsigned char* lds, const Gemm g, const Sched& S, const Epi& E) {
    const int tid = threadIdx.x, wid = __builtin_amdgcn_readfirstlane(tid >> 6), lane = tid & 63, wr = wid >> 2, wc = wid & 3, fr = lane & 15, fq = lane >> 4;
    const int K = g.K; int nt = K * EB / (BK * 2); asm volatile("" : "+s"(nt));
    unsigned voffA[2], voffB[2];
#pragma unroll
    for (int i = 0; i < 2; ++i) { int R, C; stage_rc(tid * 16 + i * 8192, R, C); const int Rb = (R & ~31) + perm32(R & 31);
        voffA[i] = (unsigned)(R * K * EB + C * 2); voffB[i] = (unsigned)(Rb * K * EB + C * 2); }
    const size_t kstep = (size_t)(BK * 2);
    const size_t hstep = (size_t)HALF * K * EB;
    const size_t tstep = 2 * hstep;
    const unsigned ldsw = (unsigned)wid * 1024u;
    const int aoff = EB == 2 ? lds_byte(wr * 64 + fr, fq * 8) : lds_byte(wr * 64 + fr, fq * 16), boff = EB == 2 ? lds_byte(wc * 32 + fr, fq * 8) : lds_byte(wc * 32 + fr, fq * 16);
#define PG8_SA(b, h) (((b) * 2 + (h)) * HTB)
#define PG8_SB(b, h) ((4 + (b) * 2 + (h)) * HTB)
#define PG8_STAGE(bufoff, gbase, voff) do { _Pragma("unroll") for (int _i = 0; _i < 2; ++_i) { unsigned _o = (voff)[_i]; if constexpr (EB == 1) asm volatile("" : "+v"(_o));     \
        __builtin_amdgcn_global_load_lds((const unsigned*)((const char*)(gbase) + _o), (PG8_LAS unsigned*)(lds + (bufoff) + ldsw + _i * 8192), 16, 0, 0); } } while (0)
#define PG8_STAGE_A(bufoff, h, aptr, usenext) do { if constexpr (GATHER) { const unsigned _p = (usenext) ? tkn[h] : tkc[h]; unsigned _v[2]; \
            _v[0] = (_p & 0xffffu) * arowb + (cpk & 0xffu); _v[1] = (_p >> 16) * arowb + (cpk >> 8); PG8_STAGE(bufoff, aptr, _v); } \
        else { PG8_STAGE(bufoff, (aptr) + (h) * hstep, voffA); } } while (0)
#define PG8_LD16(off) (*(const PG8_LAS u32x4*)(lds + (off)))
#define PG8_CAT(lo, hi) __builtin_shufflevector(lo, hi, 0, 1, 2, 3, 4, 5, 6, 7)
#define PG8_LDA(dst, dst8, b, h) do { _Pragma("unroll") for (int m = 0; m < 4; ++m) { \
        if constexpr (EB == 2) { _Pragma("unroll") for (int k = 0; k < 2; ++k) dst[m][k] = *(const PG8_LAS bf16x8*)(lds + PG8_SA(b, h) + aoff + m * 2048 + k * 1024); } \
        else { const u32x4 _l = PG8_LD16(PG8_SA(b, h) + aoff + m * 2048), _h = PG8_LD16(PG8_SA(b, h) + aoff + m * 2048 + 16); dst8[m] = PG8_CAT(_l, _h); } } } while (0)
#define PG8_LDB(dst, dst8, b, h) do { _Pragma("unroll") for (int n = 0; n < 2; ++n) { \
        if constexpr (EB == 2) { _Pragma("unroll") for (int k = 0; k < 2; ++k) dst[n][k] = *(const PG8_LAS bf16x8*)(lds + PG8_SB(b, h) + boff + n * 2048 + k * 1024); } \
        else { const u32x4 _l = PG8_LD16(PG8_SB(b, h) + boff + n * 2048), _h = PG8_LD16(PG8_SB(b, h) + boff + n * 2048 + 16); dst8[n] = PG8_CAT(_l, _h); } } } while (0)
#define PG8_MMA(ai, bj, At, At8, Bt, Bt8) do { __builtin_amdgcn_s_setprio(1); _Pragma("unroll") for (int m = 0; m < 4; ++m) _Pragma("unroll") for (int n = 0; n < 2; ++n) { \
        if constexpr (EB == 2) { _Pragma("unroll") for (int k = 0; k < 2; ++k) acc[ai][bj][m][n] = __builtin_amdgcn_mfma_f32_16x16x32_bf16(Bt[n][k], At[m][k], acc[ai][bj][m][n], 0, 0, 0); } \
        else { asm volatile("v_mfma_scale_f32_16x16x128_f8f6f4 %0, %1, %2, %0, %3, %3 op_sel_hi:[0,0,0]" : "+v"(acc[ai][bj][m][n]) : "v"(Bt8[n]), "v"(At8[m]), "v"(one_scale)); } } \
        __builtin_amdgcn_s_setprio(0); } while (0)
#define PG8_WAIT_V(n) asm volatile("s_waitcnt vmcnt(" #n ")" ::: "memory")
#define PG8_WAIT_L(n) asm volatile("s_waitcnt lgkmcnt(" #n ")" ::: "memory")
#define PG8_BAR __builtin_amdgcn_s_barrier()
#define PG8_SCHED __builtin_amdgcn_sched_barrier(0)
    Unit cur, nxt; int ui = 0;
    if (!S.next(0, cur)) return;
    unsigned tkc[2] = {0u, 0u}, tkn[2] = {0u, 0u}, cpk = 0u; const unsigned arowb = (unsigned)(K * EB);
    if constexpr (GATHER) {
        int R0, C0, R1, C1; stage_rc(tid * 16, R0, C0); stage_rc(tid * 16 + 8192, R1, C1); cpk = (unsigned)(C0 * 2) | ((unsigned)(C1 * 2) << 8);
#pragma unroll
        for (int h = 0; h < 2; ++h) tkc[h] = S.arow_tok(cur, h * HALF + R0) | (S.arow_tok(cur, h * HALF + R1) << 16);
    }
    f32x4 acc[2][2][4][2];
#pragma unroll
    for (int a = 0; a < 2; ++a)
#pragma unroll
        for (int b = 0; b < 2; ++b)
#pragma unroll
            for (int m = 0; m < 4; ++m)
#pragma unroll
                for (int n = 0; n < 2; ++n) acc[a][b][m][n] = (f32x4){0.f, 0.f, 0.f, 0.f};
    const unsigned one_scale = 0x7f7f7f7fu;
    bf16x8 At[4][2], B0[2][2], B1[2][2]; u32x8 At8[4], B08[2], B18[2];
    const char* cA = GATHER ? (const char*)g.A : (const char*)g.A + (size_t)cur.pm * tstep; const char* cB = (const char*)g.Bt + (size_t)cur.pb * tstep;
    PG8_STAGE(PG8_SB(0, 0), cB, voffB); PG8_STAGE(PG8_SB(0, 1), cB + hstep, voffB); PG8_STAGE_A(PG8_SA(0, 0), 0, cA, false); PG8_STAGE_A(PG8_SA(0, 1), 1, cA, false);
    if (wr == 1) PG8_BAR;
    PG8_WAIT_V(2); PG8_BAR;
    PG8_STAGE(PG8_SB(1, 0), cB + kstep, voffB); PG8_STAGE_A(PG8_SA(1, 0), 0, cA + kstep, false); PG8_STAGE(PG8_SB(1, 1), cB + hstep + kstep, voffB);
    PG8_WAIT_V(6); PG8_BAR;
    for (;;) {
        const bool has_next = S.next(ui + 1, nxt);
        if constexpr (GATHER) { if (has_next) { int R0, C0, R1, C1; stage_rc(tid * 16, R0, C0); stage_rc(tid * 16 + 8192, R1, C1);
#pragma unroll
            for (int h = 0; h < 2; ++h) tkn[h] = S.arow_tok(nxt, h * HALF + R0) | (S.arow_tok(nxt, h * HALF + R1) << 16); } }
        const char* nA = GATHER ? (const char*)g.A : (has_next ? (const char*)g.A + (size_t)nxt.pm * tstep : cA);
        const char* nB = has_next ? (const char*)g.Bt + (size_t)nxt.pb * tstep : cB;
        for (int t = 0; t < nt; t += 2) {
            const bool last = (t == nt - 2);
            const bool un = last && has_next;
            const char* a1 = cA + (size_t)(t + 1) * kstep;
            const char* a2 = last ? nA : cA + (size_t)(t + 2) * kstep; const char* b2 = last ? nB : cB + (size_t)(t + 2) * kstep;
            const char* a3 = a2 + kstep; const char* b3 = b2 + kstep;
            PG8_LDB(B0, B08, 0, 0); PG8_LDB(B1, B18, 0, 1); PG8_SCHED; PG8_LDA(At, At8, 0, 0); PG8_STAGE_A(PG8_SA(1, 1), 1, a1, false);
            PG8_WAIT_V(8); PG8_WAIT_L(0); PG8_BAR; PG8_MMA(0, 0, At, At8, B0, B08); PG8_MMA(0, 1, At, At8, B1, B18); PG8_BAR; PG8_SCHED;
            PG8_LDA(At, At8, 0, 1); PG8_STAGE(PG8_SB(0, 0), b2, voffB); PG8_STAGE(PG8_SB(0, 1), b2 + hstep, voffB); PG8_STAGE_A(PG8_SA(0, 0), 0, a2, un);
            PG8_WAIT_V(8); PG8_WAIT_L(0); PG8_BAR; PG8_MMA(1, 0, At, At8, B0, B08); PG8_MMA(1, 1, At, At8, B1, B18); PG8_BAR; PG8_SCHED;
            PG8_LDB(B0, B08, 1, 0); PG8_LDB(B1, B18, 1, 1); PG8_SCHED; PG8_LDA(At, At8, 1, 0); PG8_STAGE_A(PG8_SA(0, 1), 1, a2, un);
            PG8_WAIT_V(8); PG8_WAIT_L(0); PG8_BAR; PG8_MMA(0, 0, At, At8, B0, B08); PG8_MMA(0, 1, At, At8, B1, B18); PG8_BAR; PG8_SCHED;
            PG8_LDA(At, At8, 1, 1); PG8_STAGE(PG8_SB(1, 0), b3, voffB); PG8_STAGE(PG8_SB(1, 1), b3 + hstep, voffB); PG8_STAGE_A(PG8_SA(1, 0), 0, a3, un);
            PG8_WAIT_V(8); PG8_WAIT_L(0); PG8_BAR; PG8_MMA(1, 0, At, At8, B0, B08); PG8_MMA(1, 1, At, At8, B1, B18); PG8_BAR; PG8_SCHED;
        }
        if (wr == 0) PG8_BAR;
        if constexpr (EB == 1) asm volatile("s_nop 15\n\ts_nop 7" ::: "memory");
        E(acc, cur, wr, wc, fr, fq);
        S.done_unit(cur);
        if (!has_next) break;
#pragma unroll
        for (int a = 0; a < 2; ++a)
#pragma unroll
            for (int b = 0; b < 2; ++b)
#pragma unroll
                for (int m = 0; m < 4; ++m)
#pragma unroll
                    for (int n = 0; n < 2; ++n) acc[a][b][m][n] = (f32x4){0.f, 0.f, 0.f, 0.f};
        cur = nxt; cA = nA; cB = nB; ++ui;
        if constexpr (GATHER) { tkc[0] = tkn[0]; tkc[1] = tkn[1]; }
        if (wr == 1) PG8_BAR;
    }
    PG8_WAIT_V(0);
    PG8_BAR;
#undef PG8_SA
#undef PG8_SB
#undef PG8_STAGE
#undef PG8_STAGE_A
#undef PG8_LDA
#undef PG8_LDB
#undef PG8_MMA
#undef PG8_LD16
#undef PG8_CAT
#undef PG8_WAIT_V
#undef PG8_WAIT_L
#undef PG8_BAR
#undef PG8_SCHED
}
}
namespace att {
using bf16x8 = __attribute__((ext_vector_type(8))) short;
using s16x4 = __attribute__((ext_vector_type(4))) short;
using f32x16 = __attribute__((ext_vector_type(16))) float;
using u32x4 = __attribute__((ext_vector_type(4))) unsigned;
using u32x2 = __attribute__((ext_vector_type(2))) unsigned;
using f32x4v = __attribute__((ext_vector_type(4))) float;
typedef unsigned short bf16;
#ifndef PROJ_PAD
#define PROJ_PAD (37 * 1024 + 256)
#endif
constexpr int SEQ = 8192, MIXP = 1024, NTOKC = 32768, TILEB = 64 * 128;
constexpr long BSTR = (long)SEQ * 128 + PROJ_PAD;
constexpr long GRPB = 4 * BSTR;
__device__ __forceinline__ const bf16* proj_slab(const bf16* PROJ, int g, int b) { return (const bf16*)((const char*)PROJ + (long)(g * 4 + b) * BSTR); }
constexpr int C_DQ = 0, C_DK = 512, C_DV = 1024, C_SQ = 1536, C_SK = 2048, C_SV = 2560;
constexpr float LOG2E = 1.4426950408889634f;
constexpr float QSCALE = 0.125f * LOG2E;
__device__ __forceinline__ int crow(int r, int hi) { return (r & 3) + 8 * (r >> 2) + 4 * hi; }
template <int OFF = 0> __device__ __forceinline__ void glds16(const void* gsrc, unsigned lds_dst) { unsigned keep;
    asm volatile("s_mov_b32 %0, m0\n\ts_mov_b32 m0, %2\n\ts_nop 0\n\tglobal_load_lds_dwordx4 %1, off offset:%c3\n\ts_mov_b32 m0, %0" : "=&s"(keep) : "v"(gsrc), "s"(lds_dst), "i"(OFF) : "memory"); }
template <int OFF = 0> __device__ __forceinline__ void glds16s(unsigned voff, const void* sbase, unsigned lds_dst) { unsigned keep;
    asm volatile("s_mov_b32 %0, m0\n\ts_mov_b32 m0, %2\n\ts_nop 0\n\tglobal_load_lds_dwordx4 %1, %3 offset:%c4\n\ts_mov_b32 m0, %0" : "=&s"(keep) : "v"(voff), "s"(lds_dst), "s"(sbase), "i"(OFF) : "memory"); }
typedef float f32x2_t __attribute__((ext_vector_type(2))); typedef __bf16 bf16x2_t __attribute__((ext_vector_type(2)));
__device__ __forceinline__ unsigned cvtpk(float lo, float hi) { f32x2_t v = {lo, hi}; bf16x2_t b = __builtin_convertvector(v, bf16x2_t); return __builtin_bit_cast(unsigned, b); }
typedef __attribute__((address_space(3))) const char* lds_cptr;
typedef __attribute__((address_space(3))) char* lds_ptr;
typedef short v4i16_t __attribute__((ext_vector_type(4)));
__device__ __forceinline__ s16x4 vtr(lds_cptr p) { return __builtin_bit_cast(s16x4, __builtin_amdgcn_ds_read_tr16_b64_v4i16((__attribute__((address_space(3))) v4i16_t*)p)); }
__device__ __forceinline__ float swap_max(float m) { auto rr = __builtin_amdgcn_permlane32_swap(__float_as_uint(m), __float_as_uint(m), false, false); return fmaxf(__uint_as_float(rr[0]), __uint_as_float(rr[1])); }
__device__ __forceinline__ float swap_sum(float m) { auto rr = __builtin_amdgcn_permlane32_swap(__float_as_uint(m), __float_as_uint(m), false, false); return __uint_as_float(rr[0]) + __uint_as_float(rr[1]); }
#define ATT_WAIT_BAR(N) asm volatile("s_waitcnt vmcnt(" #N ") lgkmcnt(0)\n\ts_barrier" ::: "memory")
#define ATT_LBAR() asm volatile("s_waitcnt lgkmcnt(0)\n\ts_barrier" ::: "memory")
#define ATT_MFMA(a, b, c) __builtin_amdgcn_mfma_f32_32x32x16_bf16(a, b, c, 0, 0, 0)

struct KQ { lds_cptr a[4]; };
__device__ __forceinline__ KQ kq_make(lds_cptr base, int r32, int hi) { KQ k;
#pragma unroll
    for (int d0 = 0; d0 < 4; ++d0) k.a[d0] = base + r32 * 128 + (((2 * d0 + hi) ^ ((r32 >> 1) & 7)) << 4);
    return k; }
__device__ __forceinline__ void qkt(f32x16& p0, f32x16& p1, const KQ& kq, int slot, const bf16x8* qr, const f32x16 z = f32x16{}) {
#pragma unroll
    for (int d0 = 0; d0 < 4; ++d0) {
        const bf16x8 b0 = *(const __attribute__((address_space(3))) bf16x8*)(kq.a[d0] + slot);
        const bf16x8 b1 = *(const __attribute__((address_space(3))) bf16x8*)(kq.a[d0] + slot + 4096);
        if (d0 == 0) { p0 = ATT_MFMA(b0, qr[0], z); p1 = ATT_MFMA(b1, qr[0], z); }
        else { p0 = ATT_MFMA(b0, qr[d0], p0); p1 = ATT_MFMA(b1, qr[d0], p1); } }
}
template <int NDB, bool FENCE = true> __device__ __forceinline__ void pv(f32x16* o, lds_cptr vp, const u32x4* pw) {
#pragma unroll
    for (int db = 0; db < NDB; ++db) {
#pragma unroll
        for (int ks = 0; ks < 4; ++ks) {
            const s16x4 lo = vtr(vp + db * 4096 + ks * 1024), hi = vtr(vp + db * 4096 + ks * 1024 + 512);
            const bf16x8 vf = (bf16x8){lo[0], lo[1], lo[2], lo[3], hi[0], hi[1], hi[2], hi[3]};
            o[db] = ATT_MFMA(vf, __builtin_bit_cast(bf16x8, pw[ks]), o[db]); }
        if (FENCE) __builtin_amdgcn_sched_barrier(0); }
}
__device__ __forceinline__ void pack_p(u32x4* pw, const f32x16& p0, const f32x16& p1) {
    pw[0] = (u32x4){cvtpk(p0[0], p0[1]), cvtpk(p0[2], p0[3]), cvtpk(p0[4], p0[5]), cvtpk(p0[6], p0[7])};
    pw[1] = (u32x4){cvtpk(p0[8], p0[9]), cvtpk(p0[10], p0[11]), cvtpk(p0[12], p0[13]), cvtpk(p0[14], p0[15])};
    pw[2] = (u32x4){cvtpk(p1[0], p1[1]), cvtpk(p1[2], p1[3]), cvtpk(p1[4], p1[5]), cvtpk(p1[6], p1[7])};
    pw[3] = (u32x4){cvtpk(p1[8], p1[9]), cvtpk(p1[10], p1[11]), cvtpk(p1[12], p1[13]), cvtpk(p1[14], p1[15])};
}

struct Tabs { const __attribute__((address_space(3))) float* btab;
              const __attribute__((address_space(3))) float* gsub;
              const __attribute__((address_space(3))) float* gsb;
              float lam; bool online; };

constexpr int DA_KSLOT = 16384, DA_VBASE = 65536, DA_VSLOT = 16384, DA_XCH = 0  , DA_STG = 65536  , DA_STG_ROW = 272;
#define DA_SBAR() __builtin_amdgcn_sched_barrier(0)
#define DA_PIN(x) asm volatile("" : "+v"(x))
__device__ __forceinline__ float da_max3(float a, float b, float c) { float r; asm("v_max3_f32 %0, %1, %2, %3" : "=v"(r) : "v"(a), "v"(b), "v"(c)); return r; }
__device__ __forceinline__ float da_rowmax(f32x16& p0, f32x16& p1) {
    asm volatile("s_nop 15\n\ts_nop 7" : "+v"(p0), "+v"(p1));
    float a = da_max3(p0[0], p0[1], p1[0]), b = da_max3(p0[2], p0[3], p1[1]); a = da_max3(a, p1[2], p1[3]);
#pragma unroll
    for (int r = 4; r < 16; r += 4) { a = da_max3(a, p0[r], p0[r + 1]); b = da_max3(b, p0[r + 2], p0[r + 3]); a = da_max3(a, p1[r], p1[r + 1]); b = da_max3(b, p1[r + 2], p1[r + 3]); }
    return swap_max(fmaxf(a, b));
}
struct DaCtx { KQ kq; lds_cptr vp0; const __attribute__((address_space(3))) float* bt; int NT, cq, qpos, hi; unsigned kvoff, vvoff, kdst, vdst; const char* kbase; const char* vbase; };
__device__ __forceinline__ void da_near_bias(f32x16& p0, f32x16& p1, const DaCtx& C, int t) {
    const int rb = 64 * t + 4 * C.hi - C.qpos;
#pragma unroll
    for (int r = 0; r < 16; ++r) { const int rel = rb + (r & 3) + 8 * (r >> 2); int i0 = rel < -128 ? -128 : rel; int i1 = rel + 32 < -128 ? -128 : rel + 32;
        p0[r] += C.bt[i0 + 128]; p1[r] += C.bt[i1 + 128]; }
}
template <bool ONLINE> __device__ __forceinline__ void da_step_plain(int t, f32x16& sc0, f32x16& sc1, f32x16& sn0, f32x16& sn1, const u32x4* pwp, u32x4* pwc, f32x16* o, float& mhat, float& l, const bf16x8* qr, const DaCtx& C) {
    if (t >= 1 && t - 1 <= C.cq) pv<4>(o, C.vp0 + ((t - 1) & 3) * DA_VSLOT, pwp);
    if (t <= C.cq) {
        if (t >= C.NT - 4) da_near_bias(sc0, sc1, C, t);
        const float mx = ONLINE ? da_rowmax(sc0, sc1) : 0.f;
        if (ONLINE && (t == 0 || __any(mx > 8.f))) {
            const float dl = t == 0 ? mx : fmaxf(mx, 0.f), f = __builtin_amdgcn_exp2f(-dl);
            mhat += dl; l *= f;
#pragma unroll
            for (int r = 0; r < 16; ++r) { sc0[r] -= dl; sc1[r] -= dl; }
            if (t != 0) {
#pragma unroll
                for (int db = 0; db < 4; ++db)
#pragma unroll
                    for (int r = 0; r < 16; ++r) o[db][r] *= f;
            }
        }
        float sa = 0.f, sb = 0.f;
#pragma unroll
        for (int r = 0; r < 16; ++r) { sc0[r] = __builtin_amdgcn_exp2f(sc0[r]); sc1[r] = __builtin_amdgcn_exp2f(sc1[r]); sa += sc0[r]; sb += sc1[r]; }
        l += sa + sb;
        pack_p(pwc, sc0, sc1);
    }
    if (t + 1 < C.NT && t + 1 <= C.cq) {
        f32x16 ci;
#pragma unroll
        for (int r = 0; r < 16; ++r) ci[r] = ONLINE ? -mhat : 0.f;
        qkt(sn0, sn1, C.kq, ((t + 1) & 3) * DA_KSLOT, qr, ci);
    }
}
template <bool PV, bool QK, bool FIRST, bool ONLINE> __device__ __forceinline__ void da_step_hot(int t, f32x16& sc0, f32x16& sc1, f32x16& sn0, f32x16& sn1, const u32x4* pwp, u32x4* pwc, f32x16* o, float& mhat, float& l, const bf16x8* qr, const DaCtx& C) {
    if (t >= C.NT - 4) da_near_bias(sc0, sc1, C, t);
    if (!ONLINE) { DA_PIN(sc0); DA_PIN(sc1); DA_SBAR(); }
    const float mx = ONLINE ? da_rowmax(sc0, sc1) : 0.f;
    const bool resc = ONLINE && (FIRST || __any(mx > 8.f)); float f = 1.f;
    if (resc) { const float dl = FIRST ? mx : fmaxf(mx, 0.f); f = __builtin_amdgcn_exp2f(-dl); mhat += dl; l *= f;
#pragma unroll
        for (int r = 0; r < 16; ++r) { sc0[r] -= dl; sc1[r] -= dl; } }
    f32x16 ci;
#pragma unroll
    for (int r = 0; r < 16; ++r) ci[r] = ONLINE ? -mhat : 0.f;
    if (ONLINE) DA_PIN(ci);
    const lds_cptr vpt = C.vp0 + ((t - 1) & 3) * DA_VSLOT; const int kslot = ((t + 1) & 3) * DA_KSLOT; const KQ& kq = C.kq;
    s16x4 fl0, fh0, fl1, fh1, fl2, fh2, fl3, fh3, fl4, fh4; bf16x8 fk0, fk1, fk2, fk3, fk4; float sa = 0.f, sb = 0.f;
#define DA_DMA(j) do { if ((j) < 2) { if (t + 3 < C.NT) { const char* _b = C.kbase + (long)(t + 3) * TILEB; const unsigned _s = (unsigned)(((t + 3) & 3) * DA_KSLOT); \
            if ((j) == 0) glds16s<0>(C.kvoff, _b, (unsigned)__builtin_amdgcn_readfirstlane(C.kdst + _s)); else glds16s<0>(C.kvoff, _b + GRPB, (unsigned)__builtin_amdgcn_readfirstlane(C.kdst + 8192 + _s)); } } \
        else { if (t + 2 < C.NT) { const char* _b = C.vbase + (long)(t + 2) * TILEB; const unsigned _s = (unsigned)(((t + 2) & 3) * DA_VSLOT); \
            if ((j) == 2) glds16s<0>(C.vvoff, _b, (unsigned)__builtin_amdgcn_readfirstlane(C.vdst + _s)); else glds16s<0>(C.vvoff, _b + GRPB, (unsigned)__builtin_amdgcn_readfirstlane(C.vdst + 8192 + _s)); } } } while (0)
    DA_SBAR();
    if constexpr (PV && QK) {
    fl0 = vtr(vpt + 0); fh0 = vtr(vpt + 512); fl1 = vtr(vpt + 1024); fh1 = vtr(vpt + 1536); DA_SBAR();
    fl2 = vtr(vpt + 2048); fh2 = vtr(vpt + 2560); o[0] = ATT_MFMA(((bf16x8){fl0[0], fl0[1], fl0[2], fl0[3], fh0[0], fh0[1], fh0[2], fh0[3]}), __builtin_bit_cast(bf16x8, pwp[0]), o[0]); sc0[0] = __builtin_amdgcn_exp2f(sc0[0]); sc0[1] = __builtin_amdgcn_exp2f(sc0[1]); DA_PIN(sa); DA_PIN(sb); DA_PIN(sc0); DA_PIN(sc1); DA_SBAR();
    fl0 = vtr(vpt + 3072); fh0 = vtr(vpt + 3584); o[0] = ATT_MFMA(((bf16x8){fl1[0], fl1[1], fl1[2], fl1[3], fh1[0], fh1[1], fh1[2], fh1[3]}), __builtin_bit_cast(bf16x8, pwp[1]), o[0]); sc0[2] = __builtin_amdgcn_exp2f(sc0[2]); sc0[3] = __builtin_amdgcn_exp2f(sc0[3]); sa += sc0[0]; sb += sc0[1]; DA_PIN(sa); DA_PIN(sb); DA_PIN(sc0); DA_PIN(sc1); DA_SBAR();
    fl1 = vtr(vpt + 4096); fh1 = vtr(vpt + 4608); o[0] = ATT_MFMA(((bf16x8){fl2[0], fl2[1], fl2[2], fl2[3], fh2[0], fh2[1], fh2[2], fh2[3]}), __builtin_bit_cast(bf16x8, pwp[2]), o[0]); sc0[4] = __builtin_amdgcn_exp2f(sc0[4]); sc0[5] = __builtin_amdgcn_exp2f(sc0[5]); sa += sc0[2]; sb += sc0[3]; DA_PIN(sa); DA_PIN(sb); DA_PIN(sc0); DA_PIN(sc1); DA_SBAR();
    fl2 = vtr(vpt + 5120); fh2 = vtr(vpt + 5632); o[0] = ATT_MFMA(((bf16x8){fl0[0], fl0[1], fl0[2], fl0[3], fh0[0], fh0[1], fh0[2], fh0[3]}), __builtin_bit_cast(bf16x8, pwp[3]), o[0]); sc0[6] = __builtin_amdgcn_exp2f(sc0[6]); sc0[7] = __builtin_amdgcn_exp2f(sc0[7]); sa += sc0[4]; sb += sc0[5]; DA_PIN(sa); DA_PIN(sb); DA_PIN(sc0); DA_PIN(sc1); DA_SBAR();
    fl0 = vtr(vpt + 6144); fh0 = vtr(vpt + 6656); o[1] = ATT_MFMA(((bf16x8){fl1[0], fl1[1], fl1[2], fl1[3], fh1[0], fh1[1], fh1[2], fh1[3]}), __builtin_bit_cast(bf16x8, pwp[0]), o[1]); sc0[8] = __builtin_amdgcn_exp2f(sc0[8]); sc0[9] = __builtin_amdgcn_exp2f(sc0[9]); sa += sc0[6]; sb += sc0[7]; DA_PIN(sa); DA_PIN(sb); DA_PIN(sc0); DA_PIN(sc1); DA_SBAR();
    fl1 = vtr(vpt + 7168); fh1 = vtr(vpt + 7680); o[1] = ATT_MFMA(((bf16x8){fl2[0], fl2[1], fl2[2], fl2[3], fh2[0], fh2[1], fh2[2], fh2[3]}), __builtin_bit_cast(bf16x8, pwp[1]), o[1]); sc0[10] = __builtin_amdgcn_exp2f(sc0[10]); sc0[11] = __builtin_amdgcn_exp2f(sc0[11]); sa += sc0[8]; sb += sc0[9]; DA_PIN(sa); DA_PIN(sb); DA_PIN(sc0); DA_PIN(sc1); DA_SBAR();
    fl2 = vtr(vpt + 8192); fh2 = vtr(vpt + 8704); o[1] = ATT_MFMA(((bf16x8){fl0[0], fl0[1], fl0[2], fl0[3], fh0[0], fh0[1], fh0[2], fh0[3]}), __builtin_bit_cast(bf16x8, pwp[2]), o[1]); sc0[12] = __builtin_amdgcn_exp2f(sc0[12]); sc0[13] = __builtin_amdgcn_exp2f(sc0[13]); sa += sc0[10]; sb += sc0[11]; DA_PIN(sa); DA_PIN(sb); DA_PIN(sc0); DA_PIN(sc1); DA_SBAR();
    fl0 = vtr(vpt + 9216); fh0 = vtr(vpt + 9728); o[1] = ATT_MFMA(((bf16x8){fl1[0], fl1[1], fl1[2], fl1[3], fh1[0], fh1[1], fh1[2], fh1[3]}), __builtin_bit_cast(bf16x8, pwp[3]), o[1]); sc0[14] = __builtin_amdgcn_exp2f(sc0[14]); sc0[15] = __builtin_amdgcn_exp2f(sc0[15]); sa += sc0[12]; sb += sc0[13]; DA_PIN(sa); DA_PIN(sb); DA_PIN(sc0); DA_PIN(sc1); DA_SBAR();
    fl1 = vtr(vpt + 10240); fh1 = vtr(vpt + 10752); o[2] = ATT_MFMA(((bf16x8){fl2[0], fl2[1], fl2[2], fl2[3], fh2[0], fh2[1], fh2[2], fh2[3]}), __builtin_bit_cast(bf16x8, pwp[0]), o[2]); sc1[0] = __builtin_amdgcn_exp2f(sc1[0]); sc1[1] = __builtin_amdgcn_exp2f(sc1[1]); sa += sc0[14]; sb += sc0[15]; DA_PIN(sa); DA_PIN(sb); DA_PIN(sc0); DA_PIN(sc1); DA_SBAR();
    fl2 = vtr(vpt + 11264); fh2 = vtr(vpt + 11776); o[2] = ATT_MFMA(((bf16x8){fl0[0], fl0[1], fl0[2], fl0[3], fh0[0], fh0[1], fh0[2], fh0[3]}), __builtin_bit_cast(bf16x8, pwp[1]), o[2]); sc1[2] = __builtin_amdgcn_exp2f(sc1[2]); sc1[3] = __builtin_amdgcn_exp2f(sc1[3]); sa += sc1[0]; sb += sc1[1]; DA_PIN(sa); DA_PIN(sb); DA_PIN(sc0); DA_PIN(sc1); DA_SBAR();
    fl0 = vtr(vpt + 12288); fh0 = vtr(vpt + 12800); o[2] = ATT_MFMA(((bf16x8){fl1[0], fl1[1], fl1[2], fl1[3], fh1[0], fh1[1], fh1[2], fh1[3]}), __builtin_bit_cast(bf16x8, pwp[2]), o[2]); sc1[4] = __builtin_amdgcn_exp2f(sc1[4]); sc1[5] = __builtin_amdgcn_exp2f(sc1[5]); sa += sc1[2]; sb += sc1[3]; DA_PIN(sa); DA_PIN(sb); DA_PIN(sc0); DA_PIN(sc1); DA_SBAR();
    fl1 = vtr(vpt + 13312); fh1 = vtr(vpt + 13824); o[2] = ATT_MFMA(((bf16x8){fl2[0], fl2[1], fl2[2], fl2[3], fh2[0], fh2[1], fh2[2], fh2[3]}), __builtin_bit_cast(bf16x8, pwp[3]), o[2]); sc1[6] = __builtin_amdgcn_exp2f(sc1[6]); sc1[7] = __builtin_amdgcn_exp2f(sc1[7]); sa += sc1[4]; sb += sc1[5]; DA_PIN(sa); DA_PIN(sb); DA_PIN(sc0); DA_PIN(sc1); DA_SBAR();
    fl2 = vtr(vpt + 14336); fh2 = vtr(vpt + 14848); o[3] = ATT_MFMA(((bf16x8){fl0[0], fl0[1], fl0[2], fl0[3], fh0[0], fh0[1], fh0[2], fh0[3]}), __builtin_bit_cast(bf16x8, pwp[0]), o[3]); sc1[8] = __builtin_amdgcn_exp2f(sc1[8]); sc1[9] = __builtin_amdgcn_exp2f(sc1[9]); sa += sc1[6]; sb += sc1[7]; DA_PIN(sa); DA_PIN(sb); DA_PIN(sc0); DA_PIN(sc1); DA_SBAR();
    fl0 = vtr(vpt + 15360); fh0 = vtr(vpt + 15872); o[3] = ATT_MFMA(((bf16x8){fl1[0], fl1[1], fl1[2], fl1[3], fh1[0], fh1[1], fh1[2], fh1[3]}), __builtin_bit_cast(bf16x8, pwp[1]), o[3]); sc1[10] = __builtin_amdgcn_exp2f(sc1[10]); sc1[11] = __builtin_amdgcn_exp2f(sc1[11]); sa += sc1[8]; sb += sc1[9]; DA_PIN(sa); DA_PIN(sb); DA_PIN(sc0); DA_PIN(sc1); DA_SBAR();
    fk1 = *(const __attribute__((address_space(3))) bf16x8*)(kq.a[0] + kslot + 0); o[3] = ATT_MFMA(((bf16x8){fl2[0], fl2[1], fl2[2], fl2[3], fh2[0], fh2[1], fh2[2], fh2[3]}), __builtin_bit_cast(bf16x8, pwp[2]), o[3]); sc1[12] = __builtin_amdgcn_exp2f(sc1[12]); sc1[13] = __builtin_amdgcn_exp2f(sc1[13]); sa += sc1[10]; sb += sc1[11]; DA_PIN(sa); DA_PIN(sb); DA_PIN(sc0); DA_PIN(sc1); DA_SBAR();
    fk2 = *(const __attribute__((address_space(3))) bf16x8*)(kq.a[0] + kslot + 4096); o[3] = ATT_MFMA(((bf16x8){fl0[0], fl0[1], fl0[2], fl0[3], fh0[0], fh0[1], fh0[2], fh0[3]}), __builtin_bit_cast(bf16x8, pwp[3]), o[3]); sc1[14] = __builtin_amdgcn_exp2f(sc1[14]); sc1[15] = __builtin_amdgcn_exp2f(sc1[15]); sa += sc1[12]; sb += sc1[13]; DA_PIN(sa); DA_PIN(sb); DA_PIN(sc0); DA_PIN(sc1); DA_SBAR();
    fk0 = *(const __attribute__((address_space(3))) bf16x8*)(kq.a[1] + kslot + 0); sn0 = ATT_MFMA(fk1, qr[0], ci); sa += sc1[14]; sb += sc1[15]; pwc[0][0] = cvtpk(sc0[0], sc0[1]); pwc[0][1] = cvtpk(sc0[2], sc0[3]); DA_PIN(pwc[0]); pwc[0][2] = cvtpk(sc0[4], sc0[5]); pwc[0][3] = cvtpk(sc0[6], sc0[7]); DA_PIN(pwc[0]); DA_PIN(sa); DA_PIN(sb); DA_SBAR();
    fk1 = *(const __attribute__((address_space(3))) bf16x8*)(kq.a[1] + kslot + 4096); sn1 = ATT_MFMA(fk2, qr[0], ci); pwc[1][0] = cvtpk(sc0[8], sc0[9]); pwc[1][1] = cvtpk(sc0[10], sc0[11]); DA_PIN(pwc[1]); pwc[1][2] = cvtpk(sc0[12], sc0[13]); pwc[1][3] = cvtpk(sc0[14], sc0[15]); DA_PIN(pwc[1]); DA_PIN(sa); DA_PIN(sb); DA_DMA(0); DA_SBAR();
    fk2 = *(const __attribute__((address_space(3))) bf16x8*)(kq.a[2] + kslot + 0); sn0 = ATT_MFMA(fk0, qr[1], sn0); pwc[2][0] = cvtpk(sc1[0], sc1[1]); pwc[2][1] = cvtpk(sc1[2], sc1[3]); DA_PIN(pwc[2]); pwc[2][2] = cvtpk(sc1[4], sc1[5]); pwc[2][3] = cvtpk(sc1[6], sc1[7]); DA_PIN(pwc[2]); DA_PIN(sa); DA_PIN(sb); DA_SBAR();
    fk0 = *(const __attribute__((address_space(3))) bf16x8*)(kq.a[2] + kslot + 4096); sn1 = ATT_MFMA(fk1, qr[1], sn1); pwc[3][0] = cvtpk(sc1[8], sc1[9]); pwc[3][1] = cvtpk(sc1[10], sc1[11]); DA_PIN(pwc[3]); pwc[3][2] = cvtpk(sc1[12], sc1[13]); pwc[3][3] = cvtpk(sc1[14], sc1[15]); DA_PIN(pwc[3]); DA_PIN(sa); DA_PIN(sb); DA_DMA(1); DA_SBAR();
    fk1 = *(const __attribute__((address_space(3))) bf16x8*)(kq.a[3] + kslot + 0); sn0 = ATT_MFMA(fk2, qr[2], sn0); DA_PIN(sa); DA_PIN(sb); DA_SBAR();
    fk2 = *(const __attribute__((address_space(3))) bf16x8*)(kq.a[3] + kslot + 4096); sn1 = ATT_MFMA(fk0, qr[2], sn1); DA_PIN(sa); DA_PIN(sb); DA_DMA(2); DA_SBAR();
    sn0 = ATT_MFMA(fk1, qr[3], sn0); DA_PIN(sa); DA_PIN(sb); DA_SBAR();
    sn1 = ATT_MFMA(fk2, qr[3], sn1); DA_PIN(sa); DA_PIN(sb); DA_DMA(3); DA_SBAR();
    } else if constexpr (PV) {
    fl0 = vtr(vpt + 0); fh0 = vtr(vpt + 512); fl1 = vtr(vpt + 1024); fh1 = vtr(vpt + 1536); DA_SBAR();
    fl2 = vtr(vpt + 2048); fh2 = vtr(vpt + 2560); o[0] = ATT_MFMA(((bf16x8){fl0[0], fl0[1], fl0[2], fl0[3], fh0[0], fh0[1], fh0[2], fh0[3]}), __builtin_bit_cast(bf16x8, pwp[0]), o[0]); sc0[0] = __builtin_amdgcn_exp2f(sc0[0]); sc0[1] = __builtin_amdgcn_exp2f(sc0[1]); DA_PIN(sa); DA_PIN(sb); DA_PIN(sc0); DA_PIN(sc1); DA_SBAR();
    fl0 = vtr(vpt + 3072); fh0 = vtr(vpt + 3584); o[0] = ATT_MFMA(((bf16x8){fl1[0], fl1[1], fl1[2], fl1[3], fh1[0], fh1[1], fh1[2], fh1[3]}), __builtin_bit_cast(bf16x8, pwp[1]), o[0]); sc0[2] = __builtin_amdgcn_exp2f(sc0[2]); sc0[3] = __builtin_amdgcn_exp2f(sc0[3]); sa += sc0[0]; sb += sc0[1]; DA_PIN(sa); DA_PIN(sb); DA_PIN(sc0); DA_PIN(sc1); DA_SBAR();
    fl1 = vtr(vpt + 4096); fh1 = vtr(vpt + 4608); o[0] = ATT_MFMA(((bf16x8){fl2[0], fl2[1], fl2[2], fl2[3], fh2[0], fh2[1], fh2[2], fh2[3]}), __builtin_bit_cast(bf16x8, pwp[2]), o[0]); sc0[4] = __builtin_amdgcn_exp2f(sc0[4]); sc0[5] = __builtin_amdgcn_exp2f(sc0[5]); sa += sc0[2]; sb += sc0[3]; DA_PIN(sa); DA_PIN(sb); DA_PIN(sc0); DA_PIN(sc1); DA_SBAR();
    fl2 = vtr(vpt + 5120); fh2 = vtr(vpt + 5632); o[0] = ATT_MFMA(((bf16x8){fl0[0], fl0[1], fl0[2], fl0[3], fh0[0], fh0[1], fh0[2], fh0[3]}), __builtin_bit_cast(bf16x8, pwp[3]), o[0]); sc0[6] = __builtin_amdgcn_exp2f(sc0[6]); sc0[7] = __builtin_amdgcn_exp2f(sc0[7]); sa += sc0[4]; sb += sc0[5]; DA_PIN(sa); DA_PIN(sb); DA_PIN(sc0); DA_PIN(sc1); DA_SBAR();
    fl0 = vtr(vpt + 6144); fh0 = vtr(vpt + 6656); o[1] = ATT_MFMA(((bf16x8){fl1[0], fl1[1], fl1[2], fl1[3], fh1[0], fh1[1], fh1[2], fh1[3]}), __builtin_bit_cast(bf16x8, pwp[0]), o[1]); sc0[8] = __builtin_amdgcn_exp2f(sc0[8]); sc0[9] = __builtin_amdgcn_exp2f(sc0[9]); sa += sc0[6]; sb += sc0[7]; DA_PIN(sa); DA_PIN(sb); DA_PIN(sc0); DA_PIN(sc1); DA_SBAR();
    fl1 = vtr(vpt + 7168); fh1 = vtr(vpt + 7680); o[1] = ATT_MFMA(((bf16x8){fl2[0], fl2[1], fl2[2], fl2[3], fh2[0], fh2[1], fh2[2], fh2[3]}), __builtin_bit_cast(bf16x8, pwp[1]), o[1]); sc0[10] = __builtin_amdgcn_exp2f(sc0[10]); sc0[11] = __builtin_amdgcn_exp2f(sc0[11]); sa += sc0[8]; sb += sc0[9]; DA_PIN(sa); DA_PIN(sb); DA_PIN(sc0); DA_PIN(sc1); DA_SBAR();
    fl2 = vtr(vpt + 8192); fh2 = vtr(vpt + 8704); o[1] = ATT_MFMA(((bf16x8){fl0[0], fl0[1], fl0[2], fl0[3], fh0[0], fh0[1], fh0[2], fh0[3]}), __builtin_bit_cast(bf16x8, pwp[2]), o[1]); sc0[12] = __builtin_amdgcn_exp2f(sc0[12]); sc0[13] = __builtin_amdgcn_exp2f(sc0[13]); sa += sc0[10]; sb += sc0[11]; DA_PIN(sa); DA_PIN(sb); DA_PIN(sc0); DA_PIN(sc1); DA_SBAR();
    fl0 = vtr(vpt + 9216); fh0 = vtr(vpt + 9728); o[1] = ATT_MFMA(((bf16x8){fl1[0], fl1[1], fl1[2], fl1[3], fh1[0], fh1[1], fh1[2], fh1[3]}), __builtin_bit_cast(bf16x8, pwp[3]), o[1]); sc0[14] = __builtin_amdgcn_exp2f(sc0[14]); sc0[15] = __builtin_amdgcn_exp2f(sc0[15]); sa += sc0[12]; sb += sc0[13]; DA_PIN(sa); DA_PIN(sb); DA_PIN(sc0); DA_PIN(sc1); DA_SBAR();
    fl1 = vtr(vpt + 10240); fh1 = vtr(vpt + 10752); o[2] = ATT_MFMA(((bf16x8){fl2[0], fl2[1], fl2[2], fl2[3], fh2[0], fh2[1], fh2[2], fh2[3]}), __builtin_bit_cast(bf16x8, pwp[0]), o[2]); sc1[0] = __builtin_amdgcn_exp2f(sc1[0]); sc1[1] = __builtin_amdgcn_exp2f(sc1[1]); sa += sc0[14]; sb += sc0[15]; DA_PIN(sa); DA_PIN(sb); DA_PIN(sc0); DA_PIN(sc1); DA_SBAR();
    fl2 = vtr(vpt + 11264); fh2 = vtr(vpt + 11776); o[2] = ATT_MFMA(((bf16x8){fl0[0], fl0[1], fl0[2], fl0[3], fh0[0], fh0[1], fh0[2], fh0[3]}), __builtin_bit_cast(bf16x8, pwp[1]), o[2]); sc1[2] = __builtin_amdgcn_exp2f(sc1[2]); sc1[3] = __builtin_amdgcn_exp2f(sc1[3]); sa += sc1[0]; sb += sc1[1]; DA_PIN(sa); DA_PIN(sb); DA_PIN(sc0); DA_PIN(sc1); DA_SBAR();
    fl0 = vtr(vpt + 12288); fh0 = vtr(vpt + 12800); o[2] = ATT_MFMA(((bf16x8){fl1[0], fl1[1], fl1[2], fl1[3], fh1[0], fh1[1], fh1[2], fh1[3]}), __builtin_bit_cast(bf16x8, pwp[2]), o[2]); sc1[4] = __builtin_amdgcn_exp2f(sc1[4]); sc1[5] = __builtin_amdgcn_exp2f(sc1[5]); sa += sc1[2]; sb += sc1[3]; DA_PIN(sa); DA_PIN(sb); DA_PIN(sc0); DA_PIN(sc1); DA_SBAR();
    fl1 = vtr(vpt + 13312); fh1 = vtr(vpt + 13824); o[2] = ATT_MFMA(((bf16x8){fl2[0], fl2[1], fl2[2], fl2[3], fh2[0], fh2[1], fh2[2], fh2[3]}), __builtin_bit_cast(bf16x8, pwp[3]), o[2]); sc1[6] = __builtin_amdgcn_exp2f(sc1[6]); sc1[7] = __builtin_amdgcn_exp2f(sc1[7]); sa += sc1[4]; sb += sc1[5]; DA_PIN(sa); DA_PIN(sb); DA_PIN(sc0); DA_PIN(sc1); DA_SBAR();
    fl2 = vtr(vpt + 14336); fh2 = vtr(vpt + 14848); o[3] = ATT_MFMA(((bf16x8){fl0[0], fl0[1], fl0[2], fl0[3], fh0[0], fh0[1], fh0[2], fh0[3]}), __builtin_bit_cast(bf16x8, pwp[0]), o[3]); sc1[8] = __builtin_amdgcn_exp2f(sc1[8]); sc1[9] = __builtin_amdgcn_exp2f(sc1[9]); sa += sc1[6]; sb += sc1[7]; DA_PIN(sa); DA_PIN(sb); DA_PIN(sc0); DA_PIN(sc1); DA_SBAR();
    fl0 = vtr(vpt + 15360); fh0 = vtr(vpt + 15872); o[3] = ATT_MFMA(((bf16x8){fl1[0], fl1[1], fl1[2], fl1[3], fh1[0], fh1[1], fh1[2], fh1[3]}), __builtin_bit_cast(bf16x8, pwp[1]), o[3]); sc1[10] = __builtin_amdgcn_exp2f(sc1[10]); sc1[11] = __builtin_amdgcn_exp2f(sc1[11]); sa += sc1[8]; sb += sc1[9]; DA_PIN(sa); DA_PIN(sb); DA_PIN(sc0); DA_PIN(sc1); DA_SBAR();
    o[3] = ATT_MFMA(((bf16x8){fl2[0], fl2[1], fl2[2], fl2[3], fh2[0], fh2[1], fh2[2], fh2[3]}), __builtin_bit_cast(bf16x8, pwp[2]), o[3]); sc1[12] = __builtin_amdgcn_exp2f(sc1[12]); sc1[13] = __builtin_amdgcn_exp2f(sc1[13]); sa += sc1[10]; sb += sc1[11]; DA_PIN(sa); DA_PIN(sb); DA_PIN(sc0); DA_PIN(sc1); DA_SBAR();
    o[3] = ATT_MFMA(((bf16x8){fl0[0], fl0[1], fl0[2], fl0[3], fh0[0], fh0[1], fh0[2], fh0[3]}), __builtin_bit_cast(bf16x8, pwp[3]), o[3]); sc1[14] = __builtin_amdgcn_exp2f(sc1[14]); sc1[15] = __builtin_amdgcn_exp2f(sc1[15]); sa += sc1[12]; sb += sc1[13]; DA_PIN(sa); DA_PIN(sb); DA_PIN(sc0); DA_PIN(sc1); DA_SBAR();
    sa += sc1[14]; sb += sc1[15]; pwc[0][0] = cvtpk(sc0[0], sc0[1]); pwc[0][1] = cvtpk(sc0[2], sc0[3]); DA_PIN(pwc[0]); pwc[0][2] = cvtpk(sc0[4], sc0[5]); pwc[0][3] = cvtpk(sc0[6], sc0[7]); DA_PIN(pwc[0]); DA_PIN(sa); DA_PIN(sb); DA_SBAR();
    pwc[1][0] = cvtpk(sc0[8], sc0[9]); pwc[1][1] = cvtpk(sc0[10], sc0[11]); DA_PIN(pwc[1]); pwc[1][2] = cvtpk(sc0[12], sc0[13]); pwc[1][3] = cvtpk(sc0[14], sc0[15]); DA_PIN(pwc[1]); DA_PIN(sa); DA_PIN(sb); DA_SBAR();
    pwc[2][0] = cvtpk(sc1[0], sc1[1]); pwc[2][1] = cvtpk(sc1[2], sc1[3]); DA_PIN(pwc[2]); pwc[2][2] = cvtpk(sc1[4], sc1[5]); pwc[2][3] = cvtpk(sc1[6], sc1[7]); DA_PIN(pwc[2]); DA_PIN(sa); DA_PIN(sb); DA_SBAR();
    pwc[3][0] = cvtpk(sc1[8], sc1[9]); pwc[3][1] = cvtpk(sc1[10], sc1[11]); DA_PIN(pwc[3]); pwc[3][2] = cvtpk(sc1[12], sc1[13]); pwc[3][3] = cvtpk(sc1[14], sc1[15]); DA_PIN(pwc[3]); DA_PIN(sa); DA_PIN(sb); DA_SBAR();
    } else {
    fk0 = *(const __attribute__((address_space(3))) bf16x8*)(kq.a[0] + kslot + 0); fk1 = *(const __attribute__((address_space(3))) bf16x8*)(kq.a[0] + kslot + 4096); DA_SBAR();
    fk2 = *(const __attribute__((address_space(3))) bf16x8*)(kq.a[1] + kslot + 0); sn0 = ATT_MFMA(fk0, qr[0], ci); sc0[0] = __builtin_amdgcn_exp2f(sc0[0]); sc0[1] = __builtin_amdgcn_exp2f(sc0[1]); sc0[2] = __builtin_amdgcn_exp2f(sc0[2]); sc0[3] = __builtin_amdgcn_exp2f(sc0[3]); DA_PIN(sa); DA_PIN(sb); DA_PIN(sc0); DA_PIN(sc1); DA_SBAR();
    fk0 = *(const __attribute__((address_space(3))) bf16x8*)(kq.a[1] + kslot + 4096); sn1 = ATT_MFMA(fk1, qr[0], ci); sc0[4] = __builtin_amdgcn_exp2f(sc0[4]); sc0[5] = __builtin_amdgcn_exp2f(sc0[5]); sc0[6] = __builtin_amdgcn_exp2f(sc0[6]); sc0[7] = __builtin_amdgcn_exp2f(sc0[7]); sa += sc0[0]; sb += sc0[1]; sa += sc0[2]; sb += sc0[3]; DA_PIN(sa); DA_PIN(sb); DA_PIN(sc0); DA_PIN(sc1); DA_SBAR();
    fk1 = *(const __attribute__((address_space(3))) bf16x8*)(kq.a[2] + kslot + 0); sn0 = ATT_MFMA(fk2, qr[1], sn0); sc0[8] = __builtin_amdgcn_exp2f(sc0[8]); sc0[9] = __builtin_amdgcn_exp2f(sc0[9]); sc0[10] = __builtin_amdgcn_exp2f(sc0[10]); sc0[11] = __builtin_amdgcn_exp2f(sc0[11]); sa += sc0[4]; sb += sc0[5]; sa += sc0[6]; sb += sc0[7]; DA_PIN(sa); DA_PIN(sb); DA_PIN(sc0); DA_PIN(sc1); DA_SBAR();
    fk2 = *(const __attribute__((address_space(3))) bf16x8*)(kq.a[2] + kslot + 4096); sn1 = ATT_MFMA(fk0, qr[1], sn1); sc0[12] = __builtin_amdgcn_exp2f(sc0[12]); sc0[13] = __builtin_amdgcn_exp2f(sc0[13]); sc0[14] = __builtin_amdgcn_exp2f(sc0[14]); sc0[15] = __builtin_amdgcn_exp2f(sc0[15]); sa += sc0[8]; sb += sc0[9]; sa += sc0[10]; sb += sc0[11]; DA_PIN(sa); DA_PIN(sb); DA_PIN(sc0); DA_PIN(sc1); DA_SBAR();
    fk0 = *(const __attribute__((address_space(3))) bf16x8*)(kq.a[3] + kslot + 0); sn0 = ATT_MFMA(fk1, qr[2], sn0); sc1[0] = __builtin_amdgcn_exp2f(sc1[0]); sc1[1] = __builtin_amdgcn_exp2f(sc1[1]); sc1[2] = __builtin_amdgcn_exp2f(sc1[2]); sc1[3] = __builtin_amdgcn_exp2f(sc1[3]); sa += sc0[12]; sb += sc0[13]; sa += sc0[14]; sb += sc0[15]; DA_PIN(sa); DA_PIN(sb); DA_PIN(sc0); DA_PIN(sc1); DA_SBAR();
    fk1 = *(const __attribute__((address_space(3))) bf16x8*)(kq.a[3] + kslot + 4096); sn1 = ATT_MFMA(fk2, qr[2], sn1); sc1[4] = __builtin_amdgcn_exp2f(sc1[4]); sc1[5] = __builtin_amdgcn_exp2f(sc1[5]); sc1[6] = __builtin_amdgcn_exp2f(sc1[6]); sc1[7] = __builtin_amdgcn_exp2f(sc1[7]); sa += sc1[0]; sb += sc1[1]; sa += sc1[2]; sb += sc1[3]; DA_PIN(sa); DA_PIN(sb); DA_PIN(sc0); DA_PIN(sc1); DA_SBAR();
    sn0 = ATT_MFMA(fk0, qr[3], sn0); sc1[8] = __builtin_amdgcn_exp2f(sc1[8]); sc1[9] = __builtin_amdgcn_exp2f(sc1[9]); sc1[10] = __builtin_amdgcn_exp2f(sc1[10]); sc1[11] = __builtin_amdgcn_exp2f(sc1[11]); sa += sc1[4]; sb += sc1[5]; sa += sc1[6]; sb += sc1[7]; DA_PIN(sa); DA_PIN(sb); DA_PIN(sc0); DA_PIN(sc1); DA_SBAR();
    sn1 = ATT_MFMA(fk1, qr[3], sn1); sc1[12] = __builtin_amdgcn_exp2f(sc1[12]); sc1[13] = __builtin_amdgcn_exp2f(sc1[13]); sc1[14] = __builtin_amdgcn_exp2f(sc1[14]); sc1[15] = __builtin_amdgcn_exp2f(sc1[15]); sa += sc1[8]; sb += sc1[9]; sa += sc1[10]; sb += sc1[11]; DA_PIN(sa); DA_PIN(sb); DA_PIN(sc0); DA_PIN(sc1); DA_SBAR();
    sa += sc1[12]; sb += sc1[13]; sa += sc1[14]; sb += sc1[15]; pwc[0][0] = cvtpk(sc0[0], sc0[1]); pwc[0][1] = cvtpk(sc0[2], sc0[3]); DA_PIN(pwc[0]); pwc[0][2] = cvtpk(sc0[4], sc0[5]); pwc[0][3] = cvtpk(sc0[6], sc0[7]); DA_PIN(pwc[0]); DA_PIN(sa); DA_PIN(sb); DA_SBAR();
    pwc[1][0] = cvtpk(sc0[8], sc0[9]); pwc[1][1] = cvtpk(sc0[10], sc0[11]); DA_PIN(pwc[1]); pwc[1][2] = cvtpk(sc0[12], sc0[13]); pwc[1][3] = cvtpk(sc0[14], sc0[15]); DA_PIN(pwc[1]); DA_PIN(sa); DA_PIN(sb); DA_SBAR();
    pwc[2][0] = cvtpk(sc1[0], sc1[1]); pwc[2][1] = cvtpk(sc1[2], sc1[3]); DA_PIN(pwc[2]); pwc[2][2] = cvtpk(sc1[4], sc1[5]); pwc[2][3] = cvtpk(sc1[6], sc1[7]); DA_PIN(pwc[2]); DA_PIN(sa); DA_PIN(sb); DA_SBAR();
    pwc[3][0] = cvtpk(sc1[8], sc1[9]); pwc[3][1] = cvtpk(sc1[10], sc1[11]); DA_PIN(pwc[3]); pwc[3][2] = cvtpk(sc1[12], sc1[13]); pwc[3][3] = cvtpk(sc1[14], sc1[15]); DA_PIN(pwc[3]); DA_PIN(sa); DA_PIN(sb); DA_SBAR();
    }
#undef DA_DMA
    l += sa + sb;
    if (!FIRST && PV && resc) {
#pragma unroll
        for (int db = 0; db < 4; ++db)
#pragma unroll
            for (int r = 0; r < 16; ++r) o[db][r] *= f;
    }
}
template <bool ONLINE> __device__ __forceinline__ void da_unit(int b, int h, int qb, const bf16* __restrict__ PROJ, bf16* __restrict__ MIX, char* shm, const Tabs& T) {
    const int tid = threadIdx.x; int lane = tid & 63; asm volatile("" : "+v"(lane));
    const int r32 = lane & 31, hi = lane >> 5; const int wid = __builtin_amdgcn_readfirstlane(tid >> 6);
    const int map = wid >> 2, wq = wid & 3;
    const long rowbase = (long)b * SEQ; const int q0 = qb * 128;
    const unsigned lds0 = (unsigned)(uintptr_t)shm;
    const lds_cptr shm3 = (lds_cptr)shm;
    const bf16* Qw = proj_slab(PROJ, C_DQ / 64 + 2 * h + map, b) + (q0 + wq * 32 + r32) * 64;
    bf16x8 qr[4];
#pragma unroll
    for (int d0 = 0; d0 < 4; ++d0) qr[d0] = *reinterpret_cast<const bf16x8*>(Qw + d0 * 16 + hi * 8);
    const unsigned kvoff = (unsigned)(((8 * wid + (lane >> 3)) * 64 + (((lane & 7) ^ ((4 * wid + (lane >> 4)) & 7)) << 3)) * 2);
    const unsigned vvoff = (unsigned)(((16 * (wid & 3) + (lane >> 2)) * 64 + (wid >> 2) * 32 + (lane & 3) * 8) * 2);
    const char* kbase = (const char*)proj_slab(PROJ, C_DK / 64 + 2 * h, b); const char* vbase = (const char*)proj_slab(PROJ, C_DV / 64 + 2 * h, b);
    const unsigned kdst = lds0 + wid * 1024, vdst = lds0 + DA_VBASE + wid * 1024;
    const int NT = 2 * qb + 2;
#define DA_ISSUE_K(t) do { if ((t) < NT) { const char* _b = kbase + (long)(t) * TILEB; const unsigned _s = (unsigned)(((t) & 3) * DA_KSLOT); \
        glds16s<0>(kvoff, _b, (unsigned)__builtin_amdgcn_readfirstlane(kdst + _s)); glds16s<0>(kvoff, _b + GRPB, (unsigned)__builtin_amdgcn_readfirstlane(kdst + 8192 + _s)); } } while (0)
#define DA_ISSUE_V(t) do { if ((t) < NT) { const char* _b = vbase + (long)(t) * TILEB; const unsigned _s = (unsigned)(((t) & 3) * DA_VSLOT); \
        glds16s<0>(vvoff, _b, (unsigned)__builtin_amdgcn_readfirstlane(vdst + _s)); glds16s<0>(vvoff, _b + GRPB, (unsigned)__builtin_amdgcn_readfirstlane(vdst + 8192 + _s)); } } while (0)
    DA_ISSUE_K(0); DA_ISSUE_K(1); DA_ISSUE_V(0); DA_ISSUE_K(2); DA_ISSUE_V(1);
    DaCtx C; C.kq = kq_make(shm3 + map * 8192, r32, hi);
    C.vp0 = shm3 + DA_VBASE + ((lane >> 4) & 1) * 32 + (lane & 3) * 8 + (4 * hi + ((lane & 15) >> 2)) * 64;
    C.bt = T.btab + h * 256; C.NT = NT; C.kvoff = kvoff; C.vvoff = vvoff; C.kdst = kdst; C.vdst = vdst; C.kbase = kbase; C.vbase = vbase; C.cq = 2 * qb + (wq >> 1); C.qpos = q0 + wq * 32 + r32; C.hi = hi;
    float mhat = 0.f, l = 0.f; f32x16 o[4]; o[0] = f32x16{}; o[1] = f32x16{}; o[2] = f32x16{}; o[3] = f32x16{};
    f32x16 sA0 = f32x16{}, sA1 = f32x16{}, sB0 = f32x16{}, sB1 = f32x16{}; u32x4 pA[4], pB[4];
#pragma unroll
    for (int k = 0; k < 4; ++k) { pA[k] = u32x4{}; pB[k] = u32x4{}; }
    if (NT >= 3) { ATT_WAIT_BAR(8); } else { ATT_WAIT_BAR(6); }
    qkt(sA0, sA1, C.kq, 0, qr);
    if (NT >= 3) { ATT_WAIT_BAR(6); } else { ATT_WAIT_BAR(0); }
#define DA_END(t) do { if ((t) + 3 < NT) { ATT_WAIT_BAR(6); } else { ATT_WAIT_BAR(0); } } while (0)
#define DA_STEP_BEGIN(t) do { DA_ISSUE_K((t) + 3); DA_ISSUE_V((t) + 2); } while (0)
    int t = 0;
    if (C.cq == 0) {
        DA_STEP_BEGIN(0); da_step_plain<ONLINE>(0, sA0, sA1, sB0, sB1, pB, pA, o, mhat, l, qr, C); DA_END(0);
        DA_STEP_BEGIN(1); pv<4>(o, C.vp0, pA); DA_END(1);
    } else if (C.cq & 1) {
        DA_STEP_BEGIN(0); da_step_hot<false, true, true, ONLINE>(0, sA0, sA1, sB0, sB1, pB, pA, o, mhat, l, qr, C); DA_END(0);
        for (t = 1; t + 1 < C.cq; t += 2) {
            da_step_hot<true, true, false, ONLINE>(t, sB0, sB1, sA0, sA1, pA, pB, o, mhat, l, qr, C); DA_END(t);
            da_step_hot<true, true, false, ONLINE>(t + 1, sA0, sA1, sB0, sB1, pB, pA, o, mhat, l, qr, C); DA_END(t + 1);
        }
        const int tl = C.cq;
        DA_STEP_BEGIN(tl); da_step_hot<true, false, false, ONLINE>(tl, sB0, sB1, sA0, sA1, pA, pB, o, mhat, l, qr, C); DA_END(tl);
        pv<4>(o, C.vp0 + (tl & 3) * DA_VSLOT, pB);
    } else {
        DA_STEP_BEGIN(0); da_step_hot<false, true, true, ONLINE>(0, sA0, sA1, sB0, sB1, pB, pA, o, mhat, l, qr, C); DA_END(0);
        for (t = 1; t + 2 < C.cq; t += 2) {
            da_step_hot<true, true, false, ONLINE>(t, sB0, sB1, sA0, sA1, pA, pB, o, mhat, l, qr, C); DA_END(t);
            da_step_hot<true, true, false, ONLINE>(t + 1, sA0, sA1, sB0, sB1, pB, pA, o, mhat, l, qr, C); DA_END(t + 1);
        }
        const int t1 = C.cq - 1;
        da_step_hot<true, true, false, ONLINE>(t1, sB0, sB1, sA0, sA1, pA, pB, o, mhat, l, qr, C); DA_END(t1);
        DA_STEP_BEGIN(t1 + 1); da_step_hot<true, false, false, ONLINE>(t1 + 1, sA0, sA1, sB0, sB1, pB, pA, o, mhat, l, qr, C); DA_END(t1 + 1);
        DA_STEP_BEGIN(t1 + 2); pv<4>(o, C.vp0 + ((t1 + 1) & 3) * DA_VSLOT, pA); DA_END(t1 + 2);
    }
#undef DA_STEP_BEGIN
    ATT_LBAR();
#undef DA_END
    const float linv = 1.0f / swap_sum(l);
    __attribute__((address_space(3))) float* xch = (__attribute__((address_space(3))) float*)(shm3 + DA_XCH) + wq * 4096;
    if (map == 1) {
#pragma unroll
        for (int db = 0; db < 4; ++db) {
#pragma unroll
            for (int r = 0; r < 16; ++r) xch[(db * 16 + r) * 64 + lane] = o[db][r] * linv;
            __builtin_amdgcn_sched_barrier(0); }
    }
    ATT_LBAR();
    if (map == 0) {
        float ss = 0.f;
#pragma unroll
        for (int db = 0; db < 4; ++db) {
#pragma unroll
            for (int r = 0; r < 16; ++r) { const float v = o[db][r] * linv - T.lam * xch[(db * 16 + r) * 64 + lane]; o[db][r] = v; ss += v * v; }
            __builtin_amdgcn_sched_barrier(0); }
        ss = swap_sum(ss);
        const float rn = __builtin_amdgcn_rsqf(ss * (1.0f / 128.0f) + 1e-6f);
        lds_ptr stg = (lds_ptr)shm3 + DA_STG + wq * (32 * DA_STG_ROW);
        lds_ptr stg_l = stg + r32 * DA_STG_ROW + 8 * hi; const __attribute__((address_space(3))) float* gsub_l = T.gsub + 4 * hi;
#pragma unroll
        for (int db = 0; db < 4; ++db) {
#pragma unroll
            for (int g4 = 0; g4 < 4; ++g4) { const int dc = 32 * db + 8 * g4; const int r = 4 * g4;
                const f32x4v gg = *(const __attribute__((address_space(3))) f32x4v*)(gsub_l + dc);
                u32x2 w; w.x = cvtpk(o[db][r] * rn * gg[0], o[db][r + 1] * rn * gg[1]); w.y = cvtpk(o[db][r + 2] * rn * gg[2], o[db][r + 3] * rn * gg[3]);
                *(__attribute__((address_space(3))) u32x2*)(stg_l + dc * 2) = w; }
            __builtin_amdgcn_sched_barrier(0); }
        asm volatile("s_waitcnt lgkmcnt(0)" ::: "memory");
        bf16* Mw = MIX + (rowbase + q0 + wq * 32) * MIXP + h * 128;
#pragma unroll
        for (int i = 0; i < 8; ++i) { const int row = i * 4 + (lane >> 4), ch = lane & 15; const u32x4 v = *(const __attribute__((address_space(3))) u32x4*)(stg + row * DA_STG_ROW + ch * 16);
            __builtin_nontemporal_store(v, (u32x4*)(Mw + (long)row * MIXP + ch * 8)); }
    }
    ATT_LBAR();
#undef DA_ISSUE_K
#undef DA_ISSUE_V
}

constexpr int SB_SLOT = 16384, SB_HEAD = 65536, SB_STG = 0, SB_STG_ROW = 144, SB_FLAG = 8 * 32 * 144;
constexpr float SB_EPS = 1e-12f;
__device__ __forceinline__ void sb_unit(int b, int hp, int qb, const bf16* __restrict__ PROJ, bf16* __restrict__ MIX, char* shm, const Tabs& T) {
    const int tid = threadIdx.x; int lane = tid & 63; asm volatile("" : "+v"(lane));
    const int r32 = lane & 31, hi = lane >> 5; const int wid = __builtin_amdgcn_readfirstlane(tid >> 6);
    const int hsel = wid >> 2, wq = wid & 3, h = 2 * hp + hsel;
    const long rowbase = (long)b * SEQ; const int q0 = qb * 128;
    const unsigned lds0 = (unsigned)(uintptr_t)shm + hsel * SB_HEAD;
    const lds_cptr shm3 = (lds_cptr)shm;
    const unsigned kvoff = (unsigned)(((8 * wq + (lane >> 3)) * 64 + (((lane & 7) ^ ((4 * wq + (lane >> 4)) & 7)) << 3)) * 2);
    const unsigned vvoff = (unsigned)(((16 * wq + (lane >> 2)) * 64 + (lane & 3) * 8) * 2);
    const char* kbase = (const char*)proj_slab(PROJ, C_SK / 64 + h, b); const char* vbase = (const char*)proj_slab(PROJ, C_SV / 64 + h, b);
    const unsigned kdst = lds0 + wq * 1024, vdst = lds0 + 8192 + wq * 1024;
#define SB_ISSUE(t, slot) do { const long _o = (long)(t) * TILEB; const unsigned _s = (unsigned)(slot); \
        glds16s<0>(kvoff, kbase + _o, (unsigned)__builtin_amdgcn_readfirstlane(kdst + _s)); glds16s<0>(kvoff, kbase + _o + 32 * 128, (unsigned)__builtin_amdgcn_readfirstlane(kdst + 4096 + _s)); \
        glds16s<0>(vvoff, vbase + _o, (unsigned)__builtin_amdgcn_readfirstlane(vdst + _s)); glds16s<64>(vvoff, vbase + _o, (unsigned)__builtin_amdgcn_readfirstlane(vdst + 4096 - 64 + _s)); } while (0)
    const int TTOP = 2 * qb + 1;
#pragma unroll
    for (int i = 0; i < 4; ++i) if (TTOP - i >= 0) SB_ISSUE(TTOP - i, i * SB_SLOT);
    const bf16* Qw = proj_slab(PROJ, C_SQ / 64 + h, b) + (q0 + wq * 32 + r32) * 64;
    bf16x8 qr[4];
#pragma unroll
    for (int d0 = 0; d0 < 4; ++d0) qr[d0] = *reinterpret_cast<const bf16x8*>(Qw + d0 * 16 + hi * 8);
    const KQ kq = kq_make(shm3 + hsel * SB_HEAD, r32, hi);
    const lds_cptr vp0 = shm3 + hsel * SB_HEAD + 8192 + ((lane >> 4) & 1) * 32 + (lane & 3) * 8 + (4 * hi + ((lane & 15) >> 2)) * 64;
    const int td = 2 * qb + (wq >> 1);
    const int qpos = q0 + wq * 32 + r32;
    volatile __attribute__((address_space(3))) unsigned* flags = (volatile __attribute__((address_space(3))) unsigned*)(shm3 + 131072 + 448);
    float R = 1.0f; bool done = false; f32x16 o[2]; o[0] = f32x16{}; o[1] = f32x16{};
    int it = 0;
    for (int t = TTOP; t >= 0; --t, ++it) {
        const int slot = (it & 3) * SB_SLOT;
        { const int ahead = t < 3 ? t : 3;
          if (ahead == 3) { ATT_WAIT_BAR(12); } else if (ahead == 2) { ATT_WAIT_BAR(8); } else if (ahead == 1) { ATT_WAIT_BAR(4); } else { ATT_WAIT_BAR(0); } }
        if (t <= td && !done) {
            f32x16 z0, z1;
            qkt(z0, z1, kq, slot, qr);
            f32x16 om0, om1;
#pragma unroll
            for (int r = 0; r < 16; ++r) {
                const float e0 = __builtin_amdgcn_exp2f(fminf(z0[r], 100.f)), e1 = __builtin_amdgcn_exp2f(fminf(z1[r], 100.f));
                om0[r] = __builtin_amdgcn_rcpf(1.0f + e0); om1[r] = __builtin_amdgcn_rcpf(1.0f + e1); z0[r] = e0 * om0[r]; z1[r] = e1 * om1[r]; }
            if (t == td) {
                const int kb = 64 * t + 4 * hi;
#pragma unroll
                for (int r = 0; r < 16; ++r) { const int kv = kb + (r & 3) + 8 * (r >> 2);
                    if (kv >= qpos) { om0[r] = 1.f; z0[r] = 0.f; } if (kv + 32 >= qpos) { om1[r] = 1.f; z1[r] = 0.f; } }
            }
#define SB_GROUP(OM, BE, g4) do { const float c01 = OM[4 * g4] * OM[4 * g4 + 1], c23 = OM[4 * g4 + 2] * OM[4 * g4 + 3]; const float c = c01 * c23; \
            auto rr = __builtin_amdgcn_permlane32_swap(__float_as_uint(c), __float_as_uint(c), false, false); const float clo = __uint_as_float(rr[0]), chi = __uint_as_float(rr[1]); \
            const float t1 = R * chi; const float S = hi ? R : t1; R = t1 * clo; \
            const float w2 = S * OM[4 * g4 + 3], w1 = w2 * OM[4 * g4 + 2], w0 = w1 * OM[4 * g4 + 1]; \
            BE[4 * g4 + 3] *= S; BE[4 * g4 + 2] *= w2; BE[4 * g4 + 1] *= w1; BE[4 * g4] *= w0; } while (0)
            SB_GROUP(om1, z1, 3); SB_GROUP(om1, z1, 2); SB_GROUP(om1, z1, 1); SB_GROUP(om1, z1, 0);
            SB_GROUP(om0, z0, 3); SB_GROUP(om0, z0, 2); SB_GROUP(om0, z0, 1); SB_GROUP(om0, z0, 0);
#undef SB_GROUP
            u32x4 pw[4]; pack_p(pw, z0, z1);
            pv<2>(o, vp0 + slot, pw);
            done = __all(R < SB_EPS);
        }
        if (lane == 0) flags[wid] = done ? 1u : 0u;
        ATT_LBAR();
        unsigned alld = 1u;
#pragma unroll
        for (int w = 0; w < 8; ++w) alld &= flags[w];
        if (__builtin_amdgcn_readfirstlane(alld)) break;
        if (t - 4 >= 0) SB_ISSUE(t - 4, slot);
    }
    ATT_WAIT_BAR(0);
    {
        float ss = 0.f;
#pragma unroll
        for (int db = 0; db < 2; ++db)
#pragma unroll
            for (int r = 0; r < 16; ++r) ss += o[db][r] * o[db][r];
        ss = swap_sum(ss);
        const float rn = __builtin_amdgcn_rsqf(ss * (1.0f / 64.0f) + 1e-6f);
        lds_ptr stg = (lds_ptr)shm3 + SB_STG + wid * (32 * SB_STG_ROW);
        lds_ptr stg_l = stg + r32 * SB_STG_ROW + 8 * hi; const __attribute__((address_space(3))) float* gsb_l = T.gsb + 4 * hi;
#pragma unroll
        for (int db = 0; db < 2; ++db)
#pragma unroll
            for (int g4 = 0; g4 < 4; ++g4) { const int dc = 32 * db + 8 * g4; const int r = 4 * g4;
                const f32x4v gg = *(const __attribute__((address_space(3))) f32x4v*)(gsb_l + dc);
                u32x2 w; w.x = cvtpk(o[db][r] * rn * gg[0], o[db][r + 1] * rn * gg[1]); w.y = cvtpk(o[db][r + 2] * rn * gg[2], o[db][r + 3] * rn * gg[3]);
                *(__attribute__((address_space(3))) u32x2*)(stg_l + dc * 2) = w; }
        asm volatile("s_waitcnt lgkmcnt(0)" ::: "memory");
        bf16* Mw = MIX + (rowbase + q0 + wq * 32) * MIXP + 512 + h * 64;
#pragma unroll
        for (int i = 0; i < 4; ++i) { const int row = i * 8 + (lane >> 3), ch = lane & 7; const u32x4 v = *(const __attribute__((address_space(3))) u32x4*)(stg + row * SB_STG_ROW + ch * 16);
            __builtin_nontemporal_store(v, (u32x4*)(Mw + (long)row * MIXP + ch * 8)); }
    }
    ATT_LBAR();
#undef SB_ISSUE
}
}
constexpr int NWAVES = 8;
#ifndef MK_N_LAUNCHES
#define MK_N_LAUNCHES 1
#endif
constexpr int N_PHASES = 9;
constexpr int BATCH = 4, SEQ = 8192, D = 1024, NTOK = BATCH * SEQ;
constexpr int INW = 3072, NEXP = 32, EH = 512, ECAP = 32768;
constexpr int MAXBLK = 288;
constexpr float EPS = 1e-6f;
constexpr float LAMBDA_INIT = 0.2f;

constexpr size_t MiB = 1u << 20;
constexpr size_t WS_CTL = 0, CTL_ZERO_BYTES = 1 * MiB;
constexpr size_t WS_WIN = 2 * MiB, WS_WO = 8 * MiB, WS_W13 = 10 * MiB, WS_W2 = 74 * MiB, WS_RF = 106 * MiB;
constexpr size_t WS_XN = 108 * MiB;
constexpr size_t WS_PROJ = 172 * MiB;
constexpr size_t WS_U = 172 * MiB, WS_HID = 236 * MiB, WS_X1F8 = 272 * MiB  , WS_TOKS = 308 * MiB, WS_GATES = 312 * MiB, WS_RNS = 316 * MiB, WS_REC = 320 * MiB;
constexpr size_t WS_YS = 364 * MiB, WS_END = 508 * MiB;
constexpr int CW_TMO = 0, CW_BAR = 4096, CW_Q = 8192, CW_CNT = 12288, CW_DONE = 16384  ;
constexpr int RING_OFF = 0, RING_BYTES = 131072;
constexpr int LDSCTL_OFF = RING_BYTES, MISC_OFF = LDSCTL_OFF + 320;
constexpr int TAB_OFF = RING_BYTES + 512;
constexpr int MOE_OFF = TAB_OFF + 4864;
constexpr int LDS_BYTES = 147456;
static_assert(MOE_OFF + 3 * MAXBLK * 4 + 16 <= LDS_BYTES, "LDS map");

#define GAS __attribute__((address_space(1)))
#define LAS __attribute__((address_space(3)))
typedef unsigned short bf16;
typedef unsigned v4u __attribute__((ext_vector_type(4)));
typedef unsigned v2u __attribute__((ext_vector_type(2)));
typedef float f32x4 __attribute__((ext_vector_type(4)));
typedef short bf16x8 __attribute__((ext_vector_type(8)));
typedef GAS unsigned gu32;
#define RLX_AGENT __ATOMIC_RELAXED, __HIP_MEMORY_SCOPE_AGENT
#define LDS_WAIT() asm volatile("s_waitcnt lgkmcnt(0)" ::: "memory")
#define VM_WAIT() asm volatile("s_waitcnt vmcnt(0)" ::: "memory")
__device__ __forceinline__ unsigned f2bf(float f) { unsigned u = __builtin_bit_cast(unsigned, f); return (u + 0x7fffu + ((u >> 16) & 1u)) >> 16; }
__device__ __forceinline__ unsigned pk2(float lo, float hi) { return f2bf(lo) | (f2bf(hi) << 16); }
__device__ __forceinline__ float bf2f(unsigned h) { return __builtin_bit_cast(float, h << 16); }
__device__ __forceinline__ float clamp448(float v) { return __builtin_amdgcn_fmed3f(v, -448.f, 448.f); }
__device__ __forceinline__ unsigned pk4_fp8(float a, float b, float c, float d) { int w = 0; w = __builtin_amdgcn_cvt_pk_fp8_f32(a, b, w, false); w = __builtin_amdgcn_cvt_pk_fp8_f32(c, d, w, true); return (unsigned)w; }
constexpr float W13_SCALE = 64.f, W2_SCALE = 32.f;

#define XB_TMO      128
#define XB_XCNT(j)  (256  + 64 * (j))
#define XB_XSUB(j)  (1280 + 64 * (j))
#define XB_XGEN(j)  (2304 + 64 * (j))
#define XB_TOP      3328
#define XB_TOPGEN   3392
#define XCD_BAR_WORDS 3456
#define XB_SPIN_CAP (1u << 18)
__device__ __forceinline__ unsigned xb_ld(unsigned* p)              { return __hip_atomic_load(p, __ATOMIC_RELAXED, __HIP_MEMORY_SCOPE_AGENT); }
__device__ __forceinline__ unsigned xb_add(unsigned* p, unsigned v) { return __hip_atomic_fetch_add(p, v, __ATOMIC_RELAXED, __HIP_MEMORY_SCOPE_AGENT); }
__device__ __forceinline__ unsigned xb_xcc_id() { return (unsigned)__builtin_amdgcn_s_getreg((3 << 11) | 20) & 0xFu; }
#define XB_SPIN(cond, bar) do { unsigned _sp = 0; while (cond) { __builtin_amdgcn_s_sleep(1); \
    if ((++_sp & 255u) == 0u) { if (xb_ld(&(bar)[XB_TMO])) break; if (_sp > XB_SPIN_CAP) { atomicAdd(&(bar)[XB_TMO], 1u); break; } } } } while (0)
struct XcdBarrier { unsigned* bar; unsigned x; volatile LAS unsigned* st; };
__device__ __forceinline__ XcdBarrier xcd_barrier_post(unsigned* bar, volatile LAS unsigned* st) {
    XcdBarrier b; b.bar = bar; b.x = xb_xcc_id(); b.st = st;
    if (threadIdx.x == 0) st[4] = xb_add(&bar[XB_XCNT(b.x)], 1u);
    return b;
}
__device__ __forceinline__ void xcd_barrier_complete(unsigned* bar, unsigned x, unsigned& nloc, unsigned& nx) {
    const unsigned G = gridDim.x * gridDim.y * gridDim.z;
    unsigned sum, cnt, mine, sp = 0u;
    for (;;) {
        sum = 0u; cnt = 0u; mine = 0u;
#pragma unroll
        for (unsigned j = 0; j < 16; ++j) { const unsigned c = xb_ld(&bar[XB_XCNT(j)]); sum += c; cnt += (c > 0u) ? 1u : 0u; mine = (j == x) ? c : mine; }
        if (sum == G) break;
        __builtin_amdgcn_s_sleep(1);
        if ((++sp & 255u) == 0u) { if (xb_ld(&bar[XB_TMO])) break; if (sp > XB_SPIN_CAP) { atomicAdd(&bar[XB_TMO], 1u); break; } }
    }
    nloc = mine > 0u ? mine : 1u; nx = cnt > 0u ? cnt : 1u;
}
__device__ __forceinline__ void xcd_barrier(const XcdBarrier& b) {
    asm volatile("s_waitcnt vmcnt(0)" ::: "memory");
    __syncthreads();
    if (threadIdx.x == 0) {
        unsigned* bar = b.bar;
        __builtin_amdgcn_s_waitcnt(0);
        unsigned nloc = b.st[0], nx = b.st[1];
        if (nloc == 0u) { xcd_barrier_complete(bar, b.x, nloc, nx); b.st[0] = nloc; b.st[1] = nx; }
        const unsigned old = xb_add(&bar[XB_XSUB(b.x)], 1u);
        const unsigned gen = old / nloc;
        if (old + 1u == (gen + 1u) * nloc) {
            __builtin_amdgcn_fence(__ATOMIC_RELEASE, "agent");
            asm volatile("s_waitcnt vmcnt(0)" ::: "memory");
            const unsigned og = xb_add(&bar[XB_TOP], 1u);
            const unsigned tg = og / nx;
            if (og + 1u == (tg + 1u) * nx) xb_add(&bar[XB_TOPGEN], 1u);
            else XB_SPIN(xb_ld(&bar[XB_TOPGEN]) == tg, bar);
            __builtin_amdgcn_fence(__ATOMIC_ACQUIRE, "agent");
            xb_add(&bar[XB_XGEN(b.x)], 1u);
            asm volatile("s_waitcnt vmcnt(0)" ::: "memory");
        } else {
            XB_SPIN(xb_ld(&bar[XB_XGEN(b.x)]) == gen, bar);
            __builtin_amdgcn_fence(__ATOMIC_ACQUIRE, "agent");
            asm volatile("s_waitcnt vmcnt(0)" ::: "memory");
        }
    }
    __syncthreads();
}

struct Args { const float* in[21]; float* out; unsigned char* ws; int ph_lo, ph_hi, rep1, pad; };
struct Frame {
    LAS unsigned char* lds;
    volatile LAS unsigned* MISC;
    gu32* ctl;
    int tid, lane, wave;
    int vcu, G;
    const Args* A;
};
enum { I_X = 0, I_GATTN, I_WIN, I_QNG, I_KNG, I_LQ1, I_LK1, I_LQ2, I_LK2, I_SUBG, I_SBG, I_RELB, I_WO, I_GFFN, I_WRG, I_BRG, I_WRE, I_BRE, I_W1, I_W3, I_W2 };

__device__ __forceinline__ float wave_sum(float v) {
#pragma unroll
    for (int o = 1; o < 64; o <<= 1) v += __shfl_xor(v, o);
    return v;
}
template <int RMODE> __device__ __forceinline__ int rmap(int n) {
    if (RMODE == 1) { const int tl = n & 255; return (n & ~255) + 128 * ((tl & 63) >> 5) + 32 * (tl >> 6) + (tl & 31); }
    if (RMODE == 2) return (n >> 7) * 256 + (n & 127);
    if (RMODE == 3) return (n >> 7) * 256 + 128 + (n & 127);
    return n;
}
template <int RMODE> __device__ __forceinline__ void p0_transpose_item_f8(const float* W, int K, int N, unsigned char* WT, LAS float* scr, int item, int lane, const float* kscale, float mul) {
    const int nblk = N / 32, kb = item / nblk, nb = item % nblk, k0 = 64 * kb, n0 = 32 * nb;
    { f32x4 v[8]; const int n4 = (lane & 7) * 4;
#pragma unroll
      for (int i = 0; i < 8; ++i) v[i] = __builtin_nontemporal_load((const GAS f32x4*)(W + (size_t)(k0 + 8 * i + (lane >> 3)) * N + n0 + n4));
#pragma unroll
      for (int i = 0; i < 8; ++i) { LAS float* d = scr + (8 * i + (lane >> 3)) * 33 + n4; d[0] = v[i].x; d[1] = v[i].y; d[2] = v[i].z; d[3] = v[i].w; } }
    LDS_WAIT(); asm volatile("" ::: "memory");
    const int c = lane & 7;
#pragma unroll
    for (int j = 0; j < 4; ++j) { const int n = (lane >> 3) + 8 * j; const LAS float* s = scr + (8 * c) * 33 + n;
        float g8[8];
#pragma unroll
        for (int q = 0; q < 8; ++q) g8[q] = (kscale ? kscale[k0 + 8 * c + q] : 1.f) * mul;
        v2u o; o.x = pk4_fp8(s[0 * 33] * g8[0], s[1 * 33] * g8[1], s[2 * 33] * g8[2], s[3 * 33] * g8[3]); o.y = pk4_fp8(s[4 * 33] * g8[4], s[5 * 33] * g8[5], s[6 * 33] * g8[6], s[7 * 33] * g8[7]);
        *(GAS v2u*)(WT + (size_t)rmap<RMODE>(n0 + n) * K + k0 + 8 * c) = o; }
    LDS_WAIT(); asm volatile("" ::: "memory");
}
template <int RMODE> __device__ __forceinline__ void p0_transpose_item(const float* W, int K, int N, bf16* WT, LAS float* scr, int item, int lane, const float* kscale = nullptr) {
    const int nblk = N / 32, kb = item / nblk, nb = item % nblk, k0 = 64 * kb, n0 = 32 * nb;
    { f32x4 v[8]; const int n4 = (lane & 7) * 4;
#pragma unroll
      for (int i = 0; i < 8; ++i) v[i] = __builtin_nontemporal_load((const GAS f32x4*)(W + (size_t)(k0 + 8 * i + (lane >> 3)) * N + n0 + n4));
#pragma unroll
      for (int i = 0; i < 8; ++i) { LAS float* d = scr + (8 * i + (lane >> 3)) * 33 + n4; d[0] = v[i].x; d[1] = v[i].y; d[2] = v[i].z; d[3] = v[i].w; } }
    LDS_WAIT(); asm volatile("" ::: "memory");
    const int c = lane & 7;
#pragma unroll
    for (int j = 0; j < 4; ++j) { const int n = (lane >> 3) + 8 * j; const LAS float* s = scr + (8 * c) * 33 + n;
        float g8[8];
#pragma unroll
        for (int q = 0; q < 8; ++q) g8[q] = kscale ? kscale[k0 + 8 * c + q] : 1.f;
        v4u o; o.x = pk2(s[0 * 33] * g8[0], s[1 * 33] * g8[1]); o.y = pk2(s[2 * 33] * g8[2], s[3 * 33] * g8[3]); o.z = pk2(s[4 * 33] * g8[4], s[5 * 33] * g8[5]); o.w = pk2(s[6 * 33] * g8[6], s[7 * 33] * g8[7]);
        *(GAS v4u*)(WT + (size_t)rmap<RMODE>(n0 + n) * K + k0 + 8 * c) = o; }
    LDS_WAIT(); asm volatile("" ::: "memory");
}
__device__ __forceinline__ void p0_prologue(Frame& F) {
    LAS float* scr = (LAS float*)(F.lds + RING_OFF + F.wave * 16384);
    const int gw = F.vcu * NWAVES + F.wave, NGW = F.G * NWAVES;
    {
        const GAS f32x4* gp = (const GAS f32x4*)F.A->in[I_GATTN] + F.lane; f32x4 gg[4];
#pragma unroll
        for (int j = 0; j < 4; ++j) gg[j] = gp[64 * j];
        for (int m = gw; m < NTOK; m += NGW) {
            const GAS f32x4* xr = (const GAS f32x4*)(F.A->in[I_X] + (size_t)m * D) + F.lane;
            f32x4 v[4]; float s = 0.f;
#pragma unroll
            for (int j = 0; j < 4; ++j) { v[j] = __builtin_nontemporal_load(xr + 64 * j); s += (v[j].x * v[j].x + v[j].y * v[j].y) + (v[j].z * v[j].z + v[j].w * v[j].w); }
            const float rn = 1.0f / sqrtf(wave_sum(s) * (1.f / D) + EPS);
            GAS v2u* o8 = (GAS v2u*)((bf16*)(F.A->ws + WS_XN) + (size_t)m * D) + F.lane;
#pragma unroll
            for (int j = 0; j < 4; ++j) { v2u w; w.x = pk2(v[j].x * rn * gg[j].x, v[j].y * rn * gg[j].y); w.y = pk2(v[j].z * rn * gg[j].z, v[j].w * rn * gg[j].w); o8[64 * j] = w; }
        }
    }
    constexpr int I_IN = (D / 64) * (INW / 32), I_O = (D / 64) * (D / 32);
    for (int it = gw; it < I_IN + I_O; it += NGW) {
        int r = it;
        if (r < I_IN) { p0_transpose_item<1>(F.A->in[I_WIN], D, INW, (bf16*)(F.A->ws + WS_WIN), scr, r, F.lane); continue; } r -= I_IN;
        p0_transpose_item<0>(F.A->in[I_WO], D, D, (bf16*)(F.A->ws + WS_WO), scr, r, F.lane);
    }
    for (int it = gw; it < 32 * 3; it += NGW) {
        const int ks = it / 3, nb = it % 3, col = (F.lane & 15) + 16 * nb, kb = 32 * ks + 8 * (F.lane >> 4);
        unsigned hw[4], lw[4];
#pragma unroll
        for (int j = 0; j < 8; j += 2) { float v[2];
#pragma unroll
            for (int q = 0; q < 2; ++q) { const int k = kb + j + q; const float w = col < 4 ? F.A->in[I_WRG][k * 4 + col] : (col < 36 ? F.A->in[I_WRE][k * 32 + col - 4] : 0.f); v[q] = w * F.A->in[I_GFFN][k]; }
            const unsigned h0 = f2bf(v[0]), h1 = f2bf(v[1]); hw[j >> 1] = h0 | (h1 << 16); lw[j >> 1] = pk2(v[0] - bf2f(h0), v[1] - bf2f(h1)); }
        GAS v4u* dst = (GAS v4u*)(F.A->ws + WS_RF) + (size_t)(it * 2) * 64 + F.lane;
        dst[0] = (v4u){hw[0], hw[1], hw[2], hw[3]}; dst[64] = (v4u){lw[0], lw[1], lw[2], lw[3]};
    }
}

using pg8::Unit;
__device__ __forceinline__ float sum_fq(float v) {
    auto a = __builtin_amdgcn_permlane16_swap(__float_as_uint(v), __float_as_uint(v), false, false); v = __uint_as_float(a[0]) + __uint_as_float(a[1]);
    auto b = __builtin_amdgcn_permlane32_swap(__float_as_uint(v), __float_as_uint(v), false, false); return __uint_as_float(b[0]) + __uint_as_float(b[1]); }
struct EpiProj {
    bf16* P; const LAS float* gt;
    static __device__ __forceinline__ void build(LAS float* gt, const float* qg, const float* kg, int tid) {
        if (tid < 256) { const int m = tid >> 6, d = tid & 63; gt[tid] = m == 1 ? qg[d] * att::QSCALE : (m == 2 ? kg[d] : (m == 3 ? att::QSCALE : 1.f)); }
        __syncthreads(); }
    __device__ __forceinline__ void operator()(const pg8::f32x4 (&acc)[2][2][4][2], const Unit& u, int wr, int wc, int fr, int fq) const {
        const int mode = u.pn < 2 ? 1 : (u.pn < 4 ? 2 : ((u.pn == 6 || u.pn == 7) ? 3 : 0));
        float gv[2][2][4];
#pragma unroll
        for (int bj = 0; bj < 2; ++bj)
#pragma unroll
            for (int n = 0; n < 2; ++n) { const f32x4 g4 = *(const LAS f32x4*)(gt + mode * 64 + 32 * bj + 8 * fq + 4 * n);
#pragma unroll
                for (int i = 0; i < 4; ++i) gv[bj][n][i] = g4[i]; }
        const int row0 = u.pm * 256 + wr * 64 + fr;
#pragma unroll
        for (int ai = 0; ai < 2; ++ai)
#pragma unroll
            for (int m = 0; m < 4; ++m) {
                float rn = 1.f;
                if (mode == 1 || mode == 2) { float ss = 0.f;
#pragma unroll
                    for (int bj = 0; bj < 2; ++bj)
#pragma unroll
                        for (int n = 0; n < 2; ++n) { const pg8::f32x4 x = acc[ai][bj][m][n]; ss += (x[0] * x[0] + x[1] * x[1]) + (x[2] * x[2] + x[3] * x[3]); }
                    ss = sum_fq(ss);
                    rn = __builtin_amdgcn_rsqf(ss * (1.f / 64.f) + EPS); }
                bf16* rowp = (bf16*)((char*)P + (size_t)((4 * u.pn + wc) * 4 + (u.pm >> 5)) * att::BSTR) + ((row0 & 8191) + ai * 128 + m * 16) * 64 + 8 * fq;
#pragma unroll
                for (int bj = 0; bj < 2; ++bj) { const pg8::f32x4 v0 = acc[ai][bj][m][0], v1 = acc[ai][bj][m][1]; pg8::u32x4 w;
                    w.x = pg8::cvt_pk_bf16(v0[0] * rn * gv[bj][0][0], v0[1] * rn * gv[bj][0][1]); w.y = pg8::cvt_pk_bf16(v0[2] * rn * gv[bj][0][2], v0[3] * rn * gv[bj][0][3]);
                    w.z = pg8::cvt_pk_bf16(v1[0] * rn * gv[bj][1][0], v1[1] * rn * gv[bj][1][1]); w.w = pg8::cvt_pk_bf16(v1[2] * rn * gv[bj][1][2], v1[3] * rn * gv[bj][1][3]);
                    *(pg8::u32x4*)(rowp + bj * 32) = w; } }
    }
};
struct EpiOut {
    const float* x; bf16* X1; unsigned char* X8;
    __device__ __forceinline__ void operator()(const pg8::f32x4 (&acc)[2][2][4][2], const Unit& u, int wr, int wc, int fr, int fq) const {
        const int row0 = u.pm * 256 + wr * 64 + fr, col0 = u.pn * 256 + wc * 32 + 8 * fq;
#pragma unroll
        for (int ai = 0; ai < 2; ++ai)
#pragma unroll
            for (int m = 0; m < 4; ++m) { const size_t off = (size_t)(row0 + ai * 128 + m * 16) * D + col0;
#pragma unroll
                for (int bj = 0; bj < 2; ++bj) {
                    const pg8::f32x4 a0 = __builtin_nontemporal_load((const pg8::f32x4*)(x + off + bj * 128)), a1 = __builtin_nontemporal_load((const pg8::f32x4*)(x + off + bj * 128 + 4));
                    const pg8::f32x4 s0 = a0 + acc[ai][bj][m][0], s1 = a1 + acc[ai][bj][m][1]; pg8::u32x4 w;
                    w.x = pg8::cvt_pk_bf16(s0[0], s0[1]); w.y = pg8::cvt_pk_bf16(s0[2], s0[3]); w.z = pg8::cvt_pk_bf16(s1[0], s1[1]); w.w = pg8::cvt_pk_bf16(s1[2], s1[3]);
                    *(pg8::u32x4*)(X1 + off + bj * 128) = w;
                    v2u w8; w8.x = pk4_fp8(clamp448(s0[0]), clamp448(s0[1]), clamp448(s0[2]), clamp448(s0[3])); w8.y = pk4_fp8(clamp448(s1[0]), clamp448(s1[1]), clamp448(s1[2]), clamp448(s1[3]));
                    *(v2u*)(X8 + off + bj * 128) = w8; } }
    }
};
__device__ __forceinline__ float silu_mul(float a, float b) { return a * __builtin_amdgcn_rcpf(1.0f + __builtin_amdgcn_exp2f(-1.4426950408889634f * a)) * b; }
constexpr float HID_SCALE = 4.f;
struct EpiGate {
    unsigned char* H; const float* rns; const float* gates;
    __device__ __forceinline__ void operator()(const pg8::f32x4 (&acc)[2][2][4][2], const Unit& u, int wr, int wc, int fr, int fq) const {
        const int col0 = u.pn * 128 + wc * 32 + 8 * fq;
        float rnv[2][4], gtv[2][4];
#pragma unroll
        for (int ai = 0; ai < 2; ++ai)
#pragma unroll
            for (int m = 0; m < 4; ++m) { const int r = ai * 128 + wr * 64 + m * 16 + fr, ri = u.a0 + (r < u.a1 ? r : 0); rnv[ai][m] = rns[ri]; gtv[ai][m] = gates[ri]; }
        __builtin_amdgcn_sched_barrier(0);
#pragma unroll
        for (int ai = 0; ai < 2; ++ai)
#pragma unroll
            for (int m = 0; m < 4; ++m) { const int r = ai * 128 + wr * 64 + m * 16 + fr; const float rn = (r < u.a1 ? rnv[ai][m] : 0.f) * (1.0f / W13_SCALE), gt = (r < u.a1 ? gtv[ai][m] : 0.f) * HID_SCALE;
                const pg8::f32x4 a0 = acc[ai][0][m][0] * rn, a1 = acc[ai][0][m][1] * rn, b0 = acc[ai][1][m][0] * (rn * gt), b1 = acc[ai][1][m][1] * (rn * gt); v2u w;
                w.x = pk4_fp8(clamp448(silu_mul(a0[0], b0[0])), clamp448(silu_mul(a0[1], b0[1])), clamp448(silu_mul(a0[2], b0[2])), clamp448(silu_mul(a0[3], b0[3])));
                w.y = pk4_fp8(clamp448(silu_mul(a1[0], b1[0])), clamp448(silu_mul(a1[1], b1[1])), clamp448(silu_mul(a1[2], b1[2])), clamp448(silu_mul(a1[3], b1[3])));
                *(v2u*)(H + (size_t)(u.pm * 256 + r) * EH + col0) = w; }
    }
};
constexpr float YS_SCALE = 16.f;
struct EpiDown {
    unsigned char* Y; const float* gates;
    __device__ __forceinline__ void operator()(const pg8::f32x4 (&acc)[2][2][4][2], const Unit& u, int wr, int wc, int fr, int fq) const {
        const int col0 = u.pn * 256 + wc * 32 + 8 * fq;
#pragma unroll
        for (int ai = 0; ai < 2; ++ai)
#pragma unroll
            for (int m = 0; m < 4; ++m) { const int r = ai * 128 + wr * 64 + m * 16 + fr; const float gt = YS_SCALE / (W2_SCALE * HID_SCALE);
#pragma unroll
                for (int bj = 0; bj < 2; ++bj) { const pg8::f32x4 v0 = acc[ai][bj][m][0] * gt, v1 = acc[ai][bj][m][1] * gt; v2u w;
                    w.x = pk4_fp8(clamp448(v0[0]), clamp448(v0[1]), clamp448(v0[2]), clamp448(v0[3])); w.y = pk4_fp8(clamp448(v1[0]), clamp448(v1[1]), clamp448(v1[2]), clamp448(v1[3]));
                    *(v2u*)(Y + (size_t)(u.pm * 256 + r) * D + col0 + bj * 128) = w; } }
    }
};
struct MoeOrder {
    pg8::StaticOrder so; const LAS int* be; const LAS int* bj; const LAS int* bn; const int* toks; unsigned rowbytes;
    __device__ __forceinline__ bool next(int i, Unit& u) const {
        if (!so.next(i, u)) return false;
        const int e = be[u.pm], j = bj[u.pm]; u.pb = e * 4 + u.pn; u.a0 = e * ECAP + 256 * j; u.a1 = bn[u.pm]; return true; }
    __device__ __forceinline__ unsigned arow_tok(const Unit& u, int r) const { return r < u.a1 ? (unsigned)toks[u.a0 + r] : 0u; }
};
template <bool REV, bool WAIT>
struct MoeOrderX {
    int start, nunits, r, n; const LAS int* be; const LAS int* bj; const LAS int* bn; const int* toks; gu32* done;
    __device__ __forceinline__ bool next(int i, Unit& u) const {
        const int k = i * n + (REV ? n - 1 - r : r); if (k >= nunits) return false;
        const int nbx = nunits >> 2, w = k & 31, fm = (k >> 5) << 3, rem = nbx - fm;
        int jb, pn; if (rem >= 8) { jb = fm + (w & 7); pn = w >> 3; } else { pn = w / rem; jb = fm + (w - pn * rem); }
        const int p = start + jb, e = be[p], j = bj[p];
        u.pm = p; u.pn = pn; u.pb = e * 4 + pn; u.a0 = e * ECAP + 256 * j; u.a1 = bn[p];
        if (WAIT) { gu32* d = done + 64 * p; unsigned sp = 0u;
            while (__hip_atomic_load(d, RLX_AGENT) < 32u) { __builtin_amdgcn_s_sleep(2); if (++sp > (1u << 22)) break; }
            asm volatile("" ::: "memory"); }
        return true; }
    __device__ __forceinline__ unsigned arow_tok(const Unit& u, int r_) const { return r_ < u.a1 ? (unsigned)toks[u.a0 + r_] : 0u; }
    __device__ __forceinline__ void done_unit(const Unit& u) const {
        if (!WAIT) { asm volatile("s_waitcnt vmcnt(0)" ::: "memory"); if ((threadIdx.x & 63) == 0) (void)__hip_atomic_fetch_add(done + 64 * u.pm, 1u, RLX_AGENT); } }
};
__device__ __forceinline__ int moe_tables(Frame& F) {
    LAS int* be = (LAS int*)(F.lds + MOE_OFF); LAS int* bj = be + MAXBLK; LAS int* bn = bj + MAXBLK; LAS int* nbp = bn + MAXBLK;
    LAS int* cl = (LAS int*)(F.lds + RING_OFF);
    if (F.tid < NEXP) cl[F.tid] = (int)__hip_atomic_load(F.ctl + CW_CNT + 64 * F.tid, RLX_AGENT);
    __syncthreads();
    if (F.tid < 64) {
        const int c = F.lane < NEXP ? cl[F.lane] : 0, nb = (c + 255) >> 8; int incl = nb;
#pragma unroll
        for (int o = 1; o < 64; o <<= 1) { const int v = __shfl_up(incl, o); if (F.lane >= o) incl += v; }
        const int p0 = incl - nb;
        for (int j = 0; j < nb; ++j) { const int p = p0 + j; if (p < MAXBLK) { be[p] = F.lane; bj[p] = j; bn[p] = (c - 256 * j) < 256 ? (c - 256 * j) : 256; } }
        const int tot = __shfl(incl, 63);
        if (F.lane == 0) *nbp = tot < MAXBLK ? tot : MAXBLK;
    }
    __syncthreads();
    return *nbp;
}

__device__ __forceinline__ void p4_router(Frame& F, int cw_cnt = CW_CNT, size_t dummy_off = 0) {
    typedef float f4 __attribute__((ext_vector_type(4)));
    LAS float* lg = (LAS float*)(F.lds + RING_OFF) + F.wave * (16 * 48);
    LAS float* ssl = (LAS float*)(F.lds + RING_OFF + 24576) + F.wave * 16;
    LAS unsigned* hist = (LAS unsigned*)(F.lds + RING_OFF + 25600);
    LAS unsigned* base = hist + 32;
    const bf16* x1 = (const bf16*)(F.A->ws + WS_U);
    const GAS v4u* rfg = (const GAS v4u*)(F.A->ws + WS_RF);
    LAS v4u* rfl = (LAS v4u*)(F.lds + RING_OFF + 32768);
    for (int g0 = (int)blockIdx.x * 128; g0 < NTOK; g0 += (int)gridDim.x * 128) {
        if (F.tid < 32) hist[F.tid] = 0u;
        const int t0 = g0 + F.wave * 16;
        f4 acc[3]; acc[0] = (f4){0.f, 0.f, 0.f, 0.f}; acc[1] = acc[0]; acc[2] = acc[0]; float ssq = 0.f;
        const GAS v4u* xr = (const GAS v4u*)(x1 + (size_t)(t0 + (F.lane & 15)) * D + 8 * (F.lane >> 4));
#pragma unroll 1
        for (int half = 0; half < 2; ++half) {
            __syncthreads();
#pragma unroll
            for (int i = 0; i < 12; ++i) rfl[i * 512 + F.tid] = rfg[(size_t)half * 6144 + i * 512 + F.tid];
            __syncthreads();
#pragma unroll 4
            for (int k2 = 0; k2 < 16; ++k2) {
                const int ks = half * 16 + k2;
                const v4u a = xr[4 * ks];
                { const float v0 = bf2f(a.x & 0xffffu), v1 = bf2f(a.x >> 16), v2 = bf2f(a.y & 0xffffu), v3 = bf2f(a.y >> 16), v4 = bf2f(a.z & 0xffffu), v5 = bf2f(a.z >> 16), v6 = bf2f(a.w & 0xffffu), v7 = bf2f(a.w >> 16);
                  ssq += (v0 * v0 + v1 * v1) + (v2 * v2 + v3 * v3) + (v4 * v4 + v5 * v5) + (v6 * v6 + v7 * v7); }
                const bf16x8 Ah = __builtin_bit_cast(bf16x8, a);
#pragma unroll
                for (int nb = 0; nb < 3; ++nb) { const bf16x8 Bh = __builtin_bit_cast(bf16x8, rfl[((k2 * 3 + nb) * 2) * 64 + F.lane]), Bl = __builtin_bit_cast(bf16x8, rfl[((k2 * 3 + nb) * 2 + 1) * 64 + F.lane]);
                    acc[nb] = __builtin_amdgcn_mfma_f32_16x16x32_bf16(Ah, Bh, acc[nb], 0, 0, 0);
                    acc[nb] = __builtin_amdgcn_mfma_f32_16x16x32_bf16(Ah, Bl, acc[nb], 0, 0, 0); }
            }
        }
        ssq += __shfl_xor(ssq, 16); ssq += __shfl_xor(ssq, 32);
        if (F.lane < 16) ssl[F.lane] = ssq;
#pragma unroll
        for (int nb = 0; nb < 3; ++nb)
#pragma unroll
            for (int r = 0; r < 4; ++r) lg[((F.lane >> 4) * 4 + r) * 48 + (F.lane & 15) + 16 * nb] = acc[nb][r];
        LDS_WAIT(); asm volatile("" ::: "memory");
        int e1 = 0, e2 = 0; unsigned r1 = 0, r2 = 0; float g1 = 0.f, g2 = 0.f, rn = 0.f;
        if (F.lane < 16) {
            rn = 1.0f / sqrtf(ssl[F.lane] * (1.f / D) + EPS);
            const LAS float* L = lg + F.lane * 48;
            float gl[4]; int gsel = 0; float gm;
#pragma unroll
            for (int j = 0; j < 4; ++j) gl[j] = L[j] * rn + F.A->in[I_BRG][j];
            gm = gl[0];
#pragma unroll
            for (int j = 1; j < 4; ++j) if (gl[j] > gm) { gm = gl[j]; gsel = j; }
            float gs = 0.f;
#pragma unroll
            for (int j = 0; j < 4; ++j) gs += expf(gl[j] - gm);
            const float pg = 1.0f / gs;
            float el[8];
#pragma unroll
            for (int j = 0; j < 8; ++j) el[j] = L[4 + 8 * gsel + j] * rn + F.A->in[I_BRE][8 * gsel + j];
            int i1 = 0; float m1 = el[0];
#pragma unroll
            for (int j = 1; j < 8; ++j) if (el[j] > m1) { m1 = el[j]; i1 = j; }
            int i2 = -1; float m2 = -INFINITY;
#pragma unroll
            for (int j = 0; j < 8; ++j) if (j != i1 && el[j] > m2) { m2 = el[j]; i2 = j; }
            const float p2 = expf(m2 - m1);
            g1 = pg / (1.0f + p2); g2 = pg * p2 / (1.0f + p2);
            e1 = gsel * 8 + i1; e2 = gsel * 8 + i2;
            r1 = atomicAdd((unsigned*)(hist + e1), 1u); r2 = atomicAdd((unsigned*)(hist + e2), 1u);
        }
        __syncthreads();
        if (F.tid < 32) { const unsigned c = hist[F.tid]; base[F.tid] = c ? __hip_atomic_fetch_add(F.ctl + cw_cnt + 64 * F.tid, c, RLX_AGENT) : 0u; }
        __syncthreads();
        if (F.lane < 16) {
            const int t = t0 + F.lane; const int s1 = (int)(base[e1] + r1), s2 = (int)(base[e2] + r2);
            int* toks = (int*)(F.A->ws + WS_TOKS + dummy_off); float* gates = (float*)(F.A->ws + WS_GATES + dummy_off); float* rns = (float*)(F.A->ws + WS_RNS + dummy_off);
            toks[e1 * ECAP + s1] = t; gates[e1 * ECAP + s1] = g1; rns[e1 * ECAP + s1] = rn;
            toks[e2 * ECAP + s2] = t; gates[e2 * ECAP + s2] = g2; rns[e2 * ECAP + s2] = rn;
            ((int4*)(F.A->ws + WS_REC + dummy_off))[t] = make_int4(e1, s1, e2, s2);
        }
        __syncthreads();
    }
}
__device__ __forceinline__ void p7_combine(Frame& F) {
    const int gw = F.vcu * NWAVES + F.wave, NGW = F.G * NWAVES;
    int ps = 0;
    { const int c = F.lane < 32 ? (int)__hip_atomic_load(F.ctl + CW_CNT + 64 * (F.lane & 31), RLX_AGENT) : 0; const int p = ((c + 255) >> 8) << 8; int incl = p;
#pragma unroll
      for (int o = 1; o < 32; o <<= 1) { const int v = __shfl_up(incl, o); if ((F.lane & 31) >= o) incl += v; }
      ps = incl - p; }
    const unsigned char* Y = (const unsigned char*)(F.A->ws + WS_YS);
    int4 rcn = gw < NTOK ? ((const int4*)(F.A->ws + WS_REC))[gw] : make_int4(0, 0, 0, 0);
    for (int t = gw; t < NTOK; t += NGW) {
        const int4 rc = rcn; if (t + NGW < NTOK) rcn = ((const int4*)(F.A->ws + WS_REC))[t + NGW];
        const int ra = __shfl(ps, rc.x) + rc.y, rb = __shfl(ps, rc.z) + rc.w;
        const GAS v2u* xr = (const GAS v2u*)((const bf16*)(F.A->ws + WS_U) + (size_t)t * D) + F.lane; GAS f32x4* orow = (GAS f32x4*)(F.A->out + (size_t)t * D) + F.lane;
        const GAS unsigned* ya = (const GAS unsigned*)(Y + (size_t)ra * D) + F.lane; const GAS unsigned* yb = (const GAS unsigned*)(Y + (size_t)rb * D) + F.lane;
#pragma unroll
        for (int j = 0; j < 4; ++j) { const v2u xv = __builtin_nontemporal_load(xr + 64 * j); f32x4 v; v.x = bf2f(xv.x & 0xffffu); v.y = bf2f(xv.x >> 16); v.z = bf2f(xv.y & 0xffffu); v.w = bf2f(xv.y >> 16);
            const unsigned a = __builtin_nontemporal_load(ya + 64 * j), b = __builtin_nontemporal_load(yb + 64 * j); f32x4 o;
            typedef float f2 __attribute__((ext_vector_type(2)));
            const f2 a0 = __builtin_amdgcn_cvt_pk_f32_fp8((int)a, false), a1 = __builtin_amdgcn_cvt_pk_f32_fp8((int)a, true), b0 = __builtin_amdgcn_cvt_pk_f32_fp8((int)b, false), b1 = __builtin_amdgcn_cvt_pk_f32_fp8((int)b, true);
            o.x = v.x + (a0.x + b0.x) * (1.0f / YS_SCALE); o.y = v.y + (a0.y + b0.y) * (1.0f / YS_SCALE); o.z = v.z + (a1.x + b1.x) * (1.0f / YS_SCALE); o.w = v.w + (a1.y + b1.y) * (1.0f / YS_SCALE); __builtin_nontemporal_store(o, orow + 64 * j); }
    }
}

__device__ __forceinline__ int rel_bucket(int rel) {
    const int n = rel < 0 ? -rel : rel; int b;
    if (n < 8) b = n;
    else { b = 8 + (int)(logf((float)n * 0.125f) / 2.772588722239781f * 8.0f); if (n == 16) b = 10; if (n == 32) b = 12; if (n == 64) b = 14; if (b > 15) b = 15; }
    return (rel > 0 ? 16 : 0) + b;
}
__device__ __forceinline__ att::Tabs mixer_tables(Frame& F) {
    LAS float* btab = (LAS float*)(F.lds + TAB_OFF); LAS float* gsub = btab + 1024; LAS float* gsb = gsub + 128;
    for (int i = F.tid; i < 1024; i += NWAVES * 64) { const int h = i >> 8, rel = (i & 255) - 128; btab[i] = (F.A->in[I_RELB][rel_bucket(rel) * 4 + h] - F.A->in[I_RELB][rel_bucket(-128) * 4 + h]) * att::LOG2E; }
    if (F.tid < 128) gsub[F.tid] = F.A->in[I_SUBG][F.tid] * (1.0f - LAMBDA_INIT);
    if (F.tid < 64) gsb[F.tid] = F.A->in[I_SBG][F.tid];
    float s1 = F.A->in[I_LQ1][F.lane] * F.A->in[I_LK1][F.lane], s2 = F.A->in[I_LQ2][F.lane] * F.A->in[I_LK2][F.lane];
    s1 = wave_sum(s1); s2 = wave_sum(s2);
    att::Tabs T; T.btab = btab; T.gsub = gsub; T.gsb = gsb; T.lam = expf(s1) - expf(s2) + LAMBDA_INIT;
    { float mq = fabsf(F.A->in[I_QNG][F.lane]), mk = fabsf(F.A->in[I_KNG][F.lane]), mb = fmaxf(fabsf(F.A->in[I_RELB][F.lane]), fabsf(F.A->in[I_RELB][64 + F.lane]));
#pragma unroll
      for (int o = 1; o < 64; o <<= 1) { mq = fmaxf(mq, __shfl_xor(mq, o)); mk = fmaxf(mk, __shfl_xor(mk, o)); mb = fmaxf(mb, __shfl_xor(mb, o)); }
      const float bound = 64.f * mq * mk * att::QSCALE + 2.f * mb * att::LOG2E;
      T.online = !(bound <= 48.f); }
    __syncthreads();
    return T;
}
constexpr int NCONV = 64;
__device__ __forceinline__ void p2_convert_experts(Frame& F) {
    LAS float* scr = (LAS float*)(F.lds + RING_OFF + F.wave * 16384);
    constexpr int I_13 = (D / 64) * (EH / 32), I_2 = (EH / 64) * (D / 32), PER_E = 2 * I_13 + I_2;
    const int cw = (int)blockIdx.x * NWAVES + F.wave;
    for (int it = cw; it < NEXP * PER_E; it += NCONV * NWAVES) {
        const int e = it / PER_E; int r = it - e * PER_E;
        if (r < I_13) { p0_transpose_item_f8<2>(F.A->in[I_W1] + (size_t)e * D * EH, D, EH, (unsigned char*)(F.A->ws + WS_W13) + (size_t)e * 1024 * D, scr, r, F.lane, F.A->in[I_GFFN], W13_SCALE); continue; } r -= I_13;
        if (r < I_13) { p0_transpose_item_f8<3>(F.A->in[I_W3] + (size_t)e * D * EH, D, EH, (unsigned char*)(F.A->ws + WS_W13) + (size_t)e * 1024 * D, scr, r, F.lane, F.A->in[I_GFFN], W13_SCALE); continue; } r -= I_13;
        p0_transpose_item_f8<0>(F.A->in[I_W2] + (size_t)e * EH * D, EH, D, (unsigned char*)(F.A->ws + WS_W2) + (size_t)e * D * EH, scr, r, F.lane, nullptr, W2_SCALE);
    }
    __syncthreads();
}
__device__ __forceinline__ int mixer_dequeue(Frame& F, unsigned xcc, int qbase, int nunits, volatile LAS int* qw) {
    if (F.tid == 0) { int found = -1;
        for (int k = 0; k < 8; ++k) { const int q = (int)((xcc + k) & 7u); gu32* hw = F.ctl + CW_Q + 64 * (qbase + q);
            const unsigned i = __hip_atomic_fetch_add(hw, 1u, RLX_AGENT);
            if (i < (unsigned)nunits) { found = (q << 16) | (int)i; break; } }
        qw[0] = found; }
    __syncthreads();
    const int r = __builtin_amdgcn_readfirstlane(qw[0]);
    __syncthreads();
    return r;
}
__device__ __forceinline__ void p2_mixer(Frame& F, unsigned xcc, char* ring, int qbank = 0, bool do_da = true, bool do_sb = true) {
    const att::Tabs T = mixer_tables(F);
    const att::bf16* PROJ = (const att::bf16*)(F.A->ws + WS_PROJ); att::bf16* MIX = (att::bf16*)(F.A->ws + WS_XN);
    volatile LAS int* qw = (volatile LAS int*)(F.MISC + 16);
    if (!T.online) {
        for (;;) {
            if (!do_da) break; const int r = mixer_dequeue(F, xcc, qbank + 0, 128, qw); if (r < 0) break;
            const int xq = r >> 16, qi = r & 0xffff, bh = 2 * xq + (qi >> 6), qb = 63 - (qi & 63);
            att::da_unit<false>(bh >> 2, bh & 3, qb, PROJ, MIX, ring, T);
        }
    } else {
        for (;;) {
            if (!do_da) break; const int r = mixer_dequeue(F, xcc, qbank + 0, 128, qw); if (r < 0) break;
            const int xq = r >> 16, qi = r & 0xffff, bh = 2 * xq + (qi >> 6), qb = 63 - (qi & 63);
            att::da_unit<true>(bh >> 2, bh & 3, qb, PROJ, MIX, ring, T);
        }
    }
    for (;;) {
        if (!do_sb) break; const int r = mixer_dequeue(F, xcc, qbank + 8, 128, qw); if (r < 0) break;
        const int xq = r >> 16, j = r & 0xffff, pr = 2 * xq + (j >> 6), qb = 63 - (j & 63);
#ifndef NO_SB
        att::sb_unit(pr >> 2, pr & 3, qb, PROJ, MIX, ring, T);
#endif
    }
}
#ifndef REP_MASK
#define REP_MASK 0
#endif
__global__ void __launch_bounds__(NWAVES * 64, 2) mk_fwd(Args args) {
    extern __shared__ __attribute__((aligned(16))) unsigned char lds[];
    Frame F;
    F.lds = (LAS unsigned char*)lds;
    F.MISC = (volatile LAS unsigned*)(F.lds + MISC_OFF);
    F.tid = threadIdx.x; F.lane = F.tid & 63; F.wave = __builtin_amdgcn_readfirstlane(F.tid >> 6);
    F.G = gridDim.x; { const int bx = blockIdx.x; F.vcu = (F.G % 8 == 0) ? (bx % 8) * (F.G / 8) + bx / 8 : bx; }
    F.A = &args; F.ctl = (gu32*)(args.ws + WS_CTL);
    for (int u = F.tid; u < (LDS_BYTES - LDSCTL_OFF) / 4; u += NWAVES * 64) ((LAS unsigned*)(F.lds + LDSCTL_OFF))[u] = 0u;
    __syncthreads();
    XcdBarrier bar; bar.bar = (unsigned*)(F.ctl + CW_BAR); bar.x = xb_xcc_id(); bar.st = nullptr;
    if (MK_N_LAUNCHES == 1) bar = xcd_barrier_post((unsigned*)(F.ctl + CW_BAR), F.MISC + 8);
#define GRID_BAR() do { if (MK_N_LAUNCHES == 1) xcd_barrier(bar); } while (0)
    const int lo = args.ph_lo, hi = args.ph_hi;
#define IN(k) (lo <= (k) && (k) < hi)
#ifdef ONLY_PH
#define PH_ON(k) ((k) == ONLY_PH)
#else
#define PH_ON(k) true
#endif
#define REPS(k) (((REP_MASK >> (k)) & 1) ? 2 : 1)
    if (PH_ON(0) && IN(0)) { for (int rep = 0; rep < REPS(0); ++rep) p0_prologue(F); GRID_BAR(); }
    if (PH_ON(1) && IN(1)) {
        pg8::Gemm g{(const pg8::bf16_t*)(args.ws + WS_XN), (const pg8::bf16_t*)(args.ws + WS_WIN), D};
        pg8::StaticOrder S; S.init(NTOK / 256, INW / 256, F.G, (int)blockIdx.x);
        EpiProj::build((LAS float*)(F.lds + TAB_OFF), args.in[I_QNG], args.in[I_KNG], F.tid);
        EpiProj E{(bf16*)(args.ws + WS_PROJ), (const LAS float*)(F.lds + TAB_OFF)};
        pg8::gemm_phase<EpiProj, pg8::StaticOrder, false>(F.lds + RING_OFF, g, S, E);
        GRID_BAR();
    }
    if (PH_ON(2) && IN(2)) {
        if ((int)blockIdx.x < NCONV) p2_convert_experts(F);
        p2_mixer(F, bar.x, (char*)lds + RING_OFF);
        if (REP_MASK & 0x100) p2_mixer(F, bar.x, (char*)lds + RING_OFF, 16, true, false);
        if (REP_MASK & 0x200) p2_mixer(F, bar.x, (char*)lds + RING_OFF, 32, false, true);
        GRID_BAR(); }
    if (PH_ON(3) && IN(3)) {
        pg8::Gemm g{(const pg8::bf16_t*)(args.ws + WS_XN), (const pg8::bf16_t*)(args.ws + WS_WO), D};
        pg8::StaticOrder S; S.init(NTOK / 256, D / 256, F.G, (int)blockIdx.x);
        EpiOut E{args.in[I_X], (bf16*)(args.ws + WS_U), (unsigned char*)(args.ws + WS_X1F8)};
        for (int rep = 0; rep < REPS(3); ++rep) pg8::gemm_phase<EpiOut, pg8::StaticOrder, false>(F.lds + RING_OFF, g, S, E);
        GRID_BAR();
    }
    if (PH_ON(4) && IN(4)) { if (REP_MASK & 0x10) p4_router(F, CW_CNT + 2048, 64 * MiB); p4_router(F); GRID_BAR(); }
    if ((PH_ON(5) && IN(5)) || (PH_ON(6) && IN(6))) {
        const int NB = moe_tables(F);
        LAS int* be = (LAS int*)(F.lds + MOE_OFF);
        int start = 0, nbx = NB, rk = (int)blockIdx.x, nloc = F.G;
        if (MK_N_LAUNCHES == 1) { unsigned pre = 0u, mine = 0u, tot = 0u;
#pragma unroll
            for (unsigned j = 0; j < 16; ++j) { const unsigned c = (unsigned)__builtin_amdgcn_readfirstlane((int)xb_ld(bar.bar + XB_XCNT(j))); pre += j < bar.x ? c : 0u; mine = j == bar.x ? c : mine; tot += c; }
            start = (int)((unsigned)NB * pre / tot); nbx = (int)((unsigned)NB * (pre + mine) / tot) - start; rk = (int)F.MISC[12]; nloc = (int)mine; }
        rk = __builtin_amdgcn_readfirstlane(rk);
        gu32* done = F.ctl + CW_DONE;
        if (PH_ON(5) && IN(5)) {
            MoeOrderX<false, false> S{start, nbx * 4, rk, nloc, be, be + MAXBLK, be + 2 * MAXBLK, (const int*)(args.ws + WS_TOKS), done};
            pg8::Gemm g{(const pg8::bf16_t*)(args.ws + WS_X1F8), (const pg8::bf16_t*)(args.ws + WS_W13), D};
            EpiGate E{(unsigned char*)(args.ws + WS_HID), (const float*)(args.ws + WS_RNS), (const float*)(args.ws + WS_GATES)};
            pg8::gemm_phase<EpiGate, MoeOrderX<false, false>, true, 1>(F.lds + RING_OFF, g, S, E);
        }
        if (PH_ON(6) && IN(6)) {
            MoeOrderX<true, true> S{start, nbx * 4, rk, nloc, be, be + MAXBLK, be + 2 * MAXBLK, (const int*)(args.ws + WS_TOKS), done};
            pg8::Gemm g{(const pg8::bf16_t*)(args.ws + WS_HID), (const pg8::bf16_t*)(args.ws + WS_W2), EH};
            EpiDown E{(unsigned char*)(args.ws + WS_YS), (const float*)(args.ws + WS_GATES)};
            pg8::gemm_phase<EpiDown, MoeOrderX<true, true>, false, 1>(F.lds + RING_OFF, g, S, E);
            GRID_BAR();
        }
    }
    if (PH_ON(7) && IN(7)) { for (int rep = 0; rep < REPS(7); ++rep) p7_combine(F); }
#undef IN
#undef GRID_BAR
}

#if defined(DBG_NAIVE_ATTN)
#define PROJ_IDX(row, col) ((size_t)(((col) >> 6) * 4 + ((row) >> 13)) * (att::BSTR / 2) + (size_t)((row) & 8191) * 64 + ((col) & 63))
__global__ void __launch_bounds__(128) naive_da(const bf16* __restrict__ P, bf16* __restrict__ MIX, const float* relb, const float* subg, const float* lq1, const float* lk1, const float* lq2, const float* lk2) {
    __shared__ float sm[32 * 64 * 2 + 32 * 128];
    const int tid = threadIdx.x, qi = tid & 63, map = tid >> 6;
    const int bh = blockIdx.x >> 7, c = blockIdx.x & 127, b = bh >> 2, h = bh & 3;
    const size_t rowbase = (size_t)b * 8192; const int qpos = c * 64 + qi;
    float q[64], o[128];
    for (int d = 0; d < 64; ++d) q[d] = bf2f(P[PROJ_IDX(rowbase + qpos, h * 128 + map * 64 + d)]);
    for (int d = 0; d < 128; ++d) o[d] = 0.f;
    float m = -INFINITY, l = 0.f;
    float s1 = 0.f, s2 = 0.f; for (int d = 0; d < 64; ++d) { s1 += lq1[d] * lk1[d]; s2 += lq2[d] * lk2[d]; }
    const float lam = expf(s1) - expf(s2) + LAMBDA_INIT;
    const int nkeys = 64 * (c + 1);
    for (int k0 = 0; k0 < nkeys; k0 += 32) {
        __syncthreads();
        for (int i = tid; i < 32 * 128; i += 128) { const int j = i >> 7, d = i & 127; sm[(d >> 6) * 2048 + j * 64 + (d & 63)] = bf2f(P[PROJ_IDX(rowbase + k0 + j, 512 + h * 128 + d)]); sm[4096 + j * 128 + d] = bf2f(P[PROJ_IDX(rowbase + k0 + j, 1024 + h * 128 + d)]); }
        __syncthreads();
        for (int j = 0; j < 32; ++j) {
            float s = 0.f; const float* kr = sm + map * 2048 + j * 64;
            for (int d = 0; d < 64; ++d) s += q[d] * kr[d];
            s += relb[rel_bucket(k0 + j - qpos) * 4 + h] * att::LOG2E;
            const float mn = fmaxf(m, s), al = exp2f(m - mn), p = exp2f(s - mn);
            l = l * al + p; m = mn; const float* vr = sm + 4096 + j * 128;
            for (int d = 0; d < 128; ++d) o[d] = o[d] * al + p * vr[d];
        }
    }
    __syncthreads();
    const float li = 1.0f / l;
    if (map == 1) for (int d = 0; d < 128; ++d) sm[qi * 128 + d] = o[d] * li;
    __syncthreads();
    if (map == 0) { float ss = 0.f;
        for (int d = 0; d < 128; ++d) { o[d] = o[d] * li - lam * sm[qi * 128 + d]; ss += o[d] * o[d]; }
        const float rn = 1.0f / sqrtf(ss / 128.f + EPS);
        for (int d = 0; d < 128; ++d) MIX[(rowbase + qpos) * 1024 + h * 128 + d] = (bf16)f2bf(o[d] * rn * subg[d] * (1.0f - LAMBDA_INIT)); }
}
__global__ void __launch_bounds__(64) naive_sb(const bf16* __restrict__ P, bf16* __restrict__ MIX, const float* sbg) {
    __shared__ float sm[32 * 64 * 2];
    const int tid = threadIdx.x;
    const int bh = blockIdx.x >> 7, c = blockIdx.x & 127, b = bh >> 3, h = bh & 7;
    const size_t rowbase = (size_t)b * 8192; const int qpos = c * 64 + tid;
    float q[64], o[64];
    for (int d = 0; d < 64; ++d) { q[d] = bf2f(P[PROJ_IDX(rowbase + qpos, 1536 + h * 64 + d)]); o[d] = 0.f; }
    float between = 0.f;
    for (int k0 = 64 * c + 32; k0 >= 0; k0 -= 32) {
        __syncthreads();
        for (int i = tid; i < 32 * 64; i += 64) { const int j = i >> 6, d = i & 63; sm[j * 64 + d] = bf2f(P[PROJ_IDX(rowbase + k0 + j, 2048 + h * 64 + d)]); sm[2048 + j * 64 + d] = bf2f(P[PROJ_IDX(rowbase + k0 + j, 2560 + h * 64 + d)]); }
        __syncthreads();
        for (int j = 31; j >= 0; --j) {
            if (k0 + j >= qpos) continue;
            float s = 0.f; const float* kr = sm + j * 64;
            for (int d = 0; d < 64; ++d) s += q[d] * kr[d];
            const float z = s * 0.6931471805599453f;
            const float sp = fmaxf(z, 0.f) + log1pf(expf(-fabsf(z)));
            const float a = expf((z - sp) + between);
            between += -sp;
            const float* vr = sm + 2048 + j * 64;
            for (int d = 0; d < 64; ++d) o[d] += a * vr[d];
        }
    }
    float ss = 0.f; for (int d = 0; d < 64; ++d) ss += o[d] * o[d];
    const float rn = 1.0f / sqrtf(ss / 64.f + EPS);
    for (int d = 0; d < 64; ++d) MIX[(rowbase + qpos) * 1024 + 512 + h * 64 + d] = (bf16)f2bf(o[d] * rn * sbg[d]);
}
#endif

extern "C" void kernel_launch(void* const* d_in, const int* in_sizes, int n_in, void* d_out, int out_size, void* d_ws, size_t ws_size, hipStream_t stream) {
    static int grid = 0;
    if (grid == 0) {
        if (n_in != 21 || in_sizes[0] != NTOK * D || out_size != NTOK * D || ws_size < WS_END) { fprintf(stderr, "kernel_launch: unexpected shapes / workspace (n_in %d, ws %zu); nothing launched\n", n_in, ws_size); grid = -1; return; }
        int dev = 0, cus = 0, per_cu = 0;
        if (hipGetDevice(&dev) != hipSuccess || hipDeviceGetAttribute(&cus, hipDeviceAttributeMultiprocessorCount, dev) != hipSuccess) { grid = -1; return; }
        if (hipFuncSetAttribute((const void*)mk_fwd, hipFuncAttributeMaxDynamicSharedMemorySize, LDS_BYTES) != hipSuccess) { fprintf(stderr, "kernel_launch: hipFuncSetAttribute failed\n"); grid = -1; return; }
        if (hipOccupancyMaxActiveBlocksPerMultiprocessor(&per_cu, (const void*)mk_fwd, NWAVES * 64, LDS_BYTES) != hipSuccess || per_cu < 1) { fprintf(stderr, "kernel_launch: occupancy query reports %d workgroups per CU\n", per_cu); grid = -1; (void)hipGetLastError(); return; }
        (void)hipGetLastError();
        grid = cus;
    }
    if (grid < 0) return;
    if (hipMemsetAsync((char*)d_ws + WS_CTL, 0, CTL_ZERO_BYTES, stream) != hipSuccess) return;
    Args a{};
    for (int i = 0; i < 21; ++i) a.in[i] = (const float*)d_in[i];
    a.out = (float*)d_out; a.ws = (unsigned char*)d_ws; a.rep1 = (REP_MASK & 0x2) ? 2 : 1; a.pad = 0;
#if MK_N_LAUNCHES == 1
#if defined(PROBE_P1_RELAUNCH)
    a.ph_lo = 0; a.ph_hi = 2;
    hipLaunchKernelGGL(mk_fwd, dim3(grid), dim3(NWAVES * 64), LDS_BYTES, stream, a);
    (void)hipMemsetAsync((char*)d_ws + WS_CTL, 0, CTL_ZERO_BYTES, stream);
    a.ph_lo = 1; a.ph_hi = 8;
    hipLaunchKernelGGL(mk_fwd, dim3(grid), dim3(NWAVES * 64), LDS_BYTES, stream, a);
#else
    a.ph_lo = 0; a.ph_hi = 8;
    hipLaunchKernelGGL(mk_fwd, dim3(grid), dim3(NWAVES * 64), LDS_BYTES, stream, a);
#endif
#else
    for (int ph = 0; ph < 8; ++ph) {
#if defined(DBG_NAIVE_ATTN)
        if (ph == 2) {
            a.ph_lo = 2; a.ph_hi = 3; hipLaunchKernelGGL(mk_fwd, dim3(grid), dim3(NWAVES * 64), LDS_BYTES, stream, a);
            hipLaunchKernelGGL(naive_da, dim3(16 * 128), dim3(128), 0, stream, (const bf16*)((char*)d_ws + WS_PROJ), (bf16*)((char*)d_ws + WS_XN), (const float*)d_in[I_RELB], (const float*)d_in[I_SUBG],
                               (const float*)d_in[I_LQ1], (const float*)d_in[I_LK1], (const float*)d_in[I_LQ2], (const float*)d_in[I_LK2]);
            hipLaunchKernelGGL(naive_sb, dim3(32 * 128), dim3(64), 0, stream, (const bf16*)((char*)d_ws + WS_PROJ), (bf16*)((char*)d_ws + WS_XN), (const float*)d_in[I_SBG]);
            continue;
        }
#endif
        a.ph_lo = ph; a.ph_hi = ph + 1;
        hipLaunchKernelGGL(mk_fwd, dim3(grid), dim3(NWAVES * 64), LDS_BYTES, stream, a);
    }
#endif
}
```
